# Optimizing an MI355X kernel written in HIP

```python
import jax, jax.numpy as jnp
from jax import lax
import numpy as np

D_MODEL = 1024
BATCH = 8
SEQ = 2048
DEPTH = 4

GRID_W = 64
CTX_LEN = 256
D_MIX = 1024
FOUR_GROUPS = 4
FOUR_DIM = 64
D_FOUR = FOUR_GROUPS * FOUR_DIM
NA_HEADS = 6
NA_HEAD_DIM = 64
D_NA = NA_HEADS * NA_HEAD_DIM
NA_KH = 8
NA_KW = 16
GLA_HEADS = 4
GLA_DK = 48
GLA_DV = 96
D_GLA_K = GLA_HEADS * GLA_DK
D_GLA_V = GLA_HEADS * GLA_DV
GLA_RANK = 16
GLA_TAU = 16.0
GLA_CHUNK = 64
ROPE_BASE = 10000.0
EPS = 1e-6

IN_SIZES = (D_FOUR, D_FOUR, D_NA, D_NA, D_NA, D_NA, D_GLA_K, D_GLA_K, D_GLA_V, D_GLA_V, GLA_RANK, GLA_RANK)
D_IN = sum(IN_SIZES)
IN_SPLITS = tuple(int(s) for s in np.cumsum(IN_SIZES)[:-1])

kernel_name = "hybrid_fourier_natten_gla_dit"


def rmsnorm(x, w):
    xf = x.astype(jnp.float32)
    y = xf * lax.rsqrt(jnp.mean(xf * xf, axis=-1, keepdims=True) + EPS)
    return (y * w.astype(jnp.float32)).astype(x.dtype)


def split_heads(t, h):
    return t.reshape(t.shape[:-1] + (h, t.shape[-1] // h))


def rope_2d(t):
    L = t.shape[1]
    pos = jnp.arange(L)
    row = (pos // GRID_W).astype(jnp.float32)
    col = (pos % GRID_W).astype(jnp.float32)
    half = t.shape[-1] // 2
    n_freq = half // 2
    inv = ROPE_BASE ** (-jnp.arange(n_freq, dtype=jnp.float32) / n_freq)

    def rot(u, p):
        ang = p[:, None] * inv[None, :]
        cos = jnp.cos(ang)[None, :, None, :]
        sin = jnp.sin(ang)[None, :, None, :]
        u1, u2 = u[..., :n_freq], u[..., n_freq:]
        return jnp.concatenate([u1 * cos - u2 * sin, u1 * sin + u2 * cos], axis=-1)

    tf = t.astype(jnp.float32)
    out = jnp.concatenate([rot(tf[..., :half], row), rot(tf[..., half:], col)], axis=-1)
    return out.astype(t.dtype)


def fourier_mix(u, w_four):
    B, L, _ = u.shape
    ug = u.astype(jnp.float32).reshape(B, L, FOUR_GROUPS, FOUR_DIM)
    f = jnp.fft.fft2(ug, axes=(1, 3), norm="ortho").real
    return f.reshape(B, L, D_FOUR).astype(u.dtype) @ w_four


def neighbourhood_attention(q, k, v, kc, vc, rpb):
    B, L, H, d = q.shape
    rows = L // GRID_W
    kh = min(NA_KH, rows)
    r = np.arange(rows)
    row_start = np.clip(r - kh // 2, 0, rows - kh)
    row_idx = row_start[:, None] + np.arange(kh)[None, :]
    cq = np.arange(GRID_W)
    col_start = np.clip(cq - NA_KW // 2, 0, GRID_W - NA_KW)
    col_mask = (cq[None, :] >= col_start[:, None]) & (cq[None, :] < col_start[:, None] + NA_KW)
    row_off = row_idx - r[:, None] + NA_KH - 1
    col_off = np.clip(cq[None, :] - cq[:, None] + NA_KW - 1, 0, 2 * NA_KW - 2)
    bias = rpb[:, row_off[:, None, :, None], col_off[None, :, None, :]].astype(jnp.float32)
    bias = jnp.where(col_mask[None, None, :, None, :], bias, -jnp.inf)

    scale = d ** -0.5
    qg = q.reshape(B, rows, GRID_W, H, d) * scale
    kg = k.reshape(B, rows, GRID_W, H, d)[:, row_idx]
    vg = v.reshape(B, rows, GRID_W, H, d)[:, row_idx]
    s_loc = jnp.einsum('brqhd,brikhd->bhrqik', qg, kg).astype(jnp.float32) + bias[None]
    s_loc = s_loc.reshape(B, H, rows, GRID_W, kh * GRID_W)
    s_ctx = jnp.einsum('brqhd,bchd->bhrqc', qg, kc).astype(jnp.float32)
    p = jax.nn.softmax(jnp.concatenate([s_loc, s_ctx], axis=-1), axis=-1)
    p_loc = p[..., :kh * GRID_W].reshape(B, H, rows, GRID_W, kh, GRID_W).astype(v.dtype)
    p_ctx = p[..., kh * GRID_W:].astype(v.dtype)
    o = jnp.einsum('bhrqik,brikhd->brqhd', p_loc, vg) + jnp.einsum('bhrqc,bchd->brqhd', p_ctx, vc)
    return o.reshape(B, L, H * d)


def context_attention(qc, kc, vc):
    B, Lc, H, d = qc.shape
    s = jnp.einsum('bqhd,bkhd->bhqk', qc, kc).astype(jnp.float32) * (d ** -0.5)
    p = jax.nn.softmax(s, axis=-1).astype(vc.dtype)
    return jnp.einsum('bhqk,bkhd->bqhd', p, vc).reshape(B, Lc, H * d)


def gla_scan(q, k, v, log_a, s0):
    B, L, H, dk = q.shape
    dv = v.shape[-1]
    n = L // GLA_CHUNK

    def chunks(t):
        return t.astype(jnp.float32).reshape(B, n, GLA_CHUNK, H, t.shape[-1]).transpose(1, 0, 3, 2, 4)

    tri = jnp.tril(jnp.ones((GLA_CHUNK, GLA_CHUNK), dtype=bool))

    def step(state, inp):
        qi, ki, vi, gi = inp
        b = jnp.cumsum(gi, axis=2)
        b_end = b[:, :, -1:, :]
        q_dec = qi * jnp.exp(b)
        k_dec = ki * jnp.exp(-b)
        a = jnp.where(tri, jnp.einsum('bhtk,bhsk->bhts', q_dec, k_dec), 0.0)
        o = jnp.einsum('bhts,bhsv->bhtv', a, vi) + jnp.einsum('bhtk,bhkv->bhtv', q_dec, state)
        k_to_end = ki * jnp.exp(b_end - b)
        state = jnp.exp(b_end[:, :, 0, :])[..., None] * state + jnp.einsum('bhsk,bhsv->bhkv', k_to_end, vi)
        return state, o

    state, o = lax.scan(step, s0.astype(jnp.float32), (chunks(q), chunks(k), chunks(v), chunks(log_a)))
    o = o.transpose(1, 0, 3, 2, 4).reshape(B, L, H, dv)
    return o, state


def gla_log_decay(z, w_a, b_a):
    g = (z @ w_a + b_a).astype(jnp.float32)
    return split_heads(jax.nn.log_sigmoid(g) / GLA_TAU, GLA_HEADS)


def gla_out_norm(o, w, dtype):
    o = o * lax.rsqrt(jnp.mean(o * o, axis=-1, keepdims=True) + EPS) * w.astype(jnp.float32)
    return o.reshape(o.shape[0], o.shape[1], D_GLA_V).astype(dtype)


def setup_inputs(seed: int = 0) -> dict:
    key = jax.random.key(seed)
    ks = jax.random.split(key, 20)
    f32 = jnp.float32
    nrm = lambda k, shape, s: jax.random.normal(k, shape, f32) * s
    return {
        "x": nrm(ks[0], (BATCH, SEQ, D_MODEL), 1.0),
        "c": nrm(ks[1], (BATCH, D_MODEL), 1.0),
        "ctx": nrm(ks[2], (BATCH, CTX_LEN, D_MODEL), 1.0),
        "c_ctx": nrm(ks[3], (D_MODEL,), 1.0),
        "w_ada": nrm(ks[4], (DEPTH, D_MODEL, 3 * D_MODEL), 0.5 * D_MODEL ** -0.5),
        "b_ada": nrm(ks[5], (DEPTH, 3 * D_MODEL), 0.02),
        "norm_w": 1.0 + nrm(ks[6], (DEPTH, D_MODEL), 0.02),
        "w_in": nrm(ks[7], (DEPTH, D_MODEL, D_IN), D_MODEL ** -0.5),
        "w_four": nrm(ks[8], (DEPTH, D_FOUR, D_FOUR), D_FOUR ** -0.5),
        "rpb": nrm(ks[9], (DEPTH, NA_HEADS, 2 * NA_KH - 1, 2 * NA_KW - 1), 0.1),
        "w_alpha_fwd": nrm(ks[10], (DEPTH, GLA_RANK, D_GLA_K), GLA_RANK ** -0.5),
        "b_alpha_fwd": nrm(ks[11], (DEPTH, D_GLA_K), 0.1),
        "w_alpha_bwd": nrm(ks[12], (DEPTH, GLA_RANK, D_GLA_K), GLA_RANK ** -0.5),
        "b_alpha_bwd": nrm(ks[13], (DEPTH, D_GLA_K), 0.1),
        "gla_norm_w": 1.0 + nrm(ks[14], (DEPTH, GLA_DV), 0.02),
        "w_out": nrm(ks[15], (DEPTH, D_MIX, D_MODEL), D_MIX ** -0.5),
        "norm_f": 1.0 + nrm(ks[16], (D_MODEL,), 0.02),
    }


def reference(x, c, ctx, c_ctx, w_ada, b_ada, norm_w, w_in, w_four, rpb,
              w_alpha_fwd, b_alpha_fwd, w_alpha_bwd, b_alpha_bwd, gla_norm_w, w_out, norm_f):
    silu_c = jax.nn.silu(c)
    silu_cc = jax.nn.silu(c_ctx)
    for l in range(DEPTH):
        last = l == DEPTH - 1
        shift_x, scale_x, gate_x = jnp.split(silu_c @ w_ada[l] + b_ada[l], 3, axis=-1)
        shift_c, scale_c, gate_c = jnp.split(silu_cc @ w_ada[l] + b_ada[l], 3, axis=-1)
        hx = rmsnorm(x, norm_w[l]) * (1.0 + scale_x[:, None, :]) + shift_x[:, None, :]
        hc = rmsnorm(ctx, norm_w[l]) * (1.0 + scale_c) + shift_c

        (fx, fgx, nqx, nkx, nvx, ngx, gqx, gkx, gvx, ggx, zfx, zbx) = jnp.split(hx @ w_in[l], IN_SPLITS, axis=-1)
        (fc, fgc, nqc, nkc, nvc, ngc, gqc, gkc, gvc, ggc, zfc, zbc) = jnp.split(hc @ w_in[l], IN_SPLITS, axis=-1)

        nkc_h, nvc_h = split_heads(nkc, NA_HEADS), split_heads(nvc, NA_HEADS)
        na_x = neighbourhood_attention(split_heads(nqx, NA_HEADS), split_heads(nkx, NA_HEADS),
                                       split_heads(nvx, NA_HEADS), nkc_h, nvc_h, rpb[l])

        qx_g = rope_2d(split_heads(gqx, GLA_HEADS)) * (GLA_DK ** -0.5)
        kx_g = rope_2d(split_heads(gkx, GLA_HEADS))
        vx_g = split_heads(gvx, GLA_HEADS)
        qc_g = split_heads(gqc, GLA_HEADS) * (GLA_DK ** -0.5)
        kc_g = split_heads(gkc, GLA_HEADS)
        vc_g = split_heads(gvc, GLA_HEADS)
        la_xf = gla_log_decay(zfx, w_alpha_fwd[l], b_alpha_fwd[l])
        la_cf = gla_log_decay(zfc, w_alpha_fwd[l], b_alpha_fwd[l])
        la_xb = gla_log_decay(zbx, w_alpha_bwd[l], b_alpha_bwd[l])
        la_cb = gla_log_decay(zbc, w_alpha_bwd[l], b_alpha_bwd[l])
        s0 = jnp.zeros((x.shape[0], GLA_HEADS, GLA_DK, GLA_DV), jnp.float32)
        flip = lambda t: jnp.flip(t, axis=1)
        oc_f, sc_f = gla_scan(qc_g, kc_g, vc_g, la_cf, s0)
        ox_f, _ = gla_scan(qx_g, kx_g, vx_g, la_xf, sc_f)
        oc_b, sc_b = gla_scan(flip(qc_g), flip(kc_g), flip(vc_g), flip(la_cb), s0)
        ox_b, _ = gla_scan(flip(qx_g), flip(kx_g), flip(vx_g), flip(la_xb), sc_b)
        gla_x = gla_out_norm(ox_f + flip(ox_b), gla_norm_w[l], x.dtype)

        four_x = fourier_mix(fx, w_four[l])

        mix_x = jnp.concatenate([four_x * jax.nn.silu(fgx), na_x * jax.nn.silu(ngx),
                                 gla_x * jax.nn.silu(ggx)], axis=-1)
        x_new = x + gate_x[:, None, :] * (mix_x @ w_out[l])

        if not last:
            na_c = context_attention(split_heads(nqc, NA_HEADS), nkc_h, nvc_h)
            gla_c = gla_out_norm(oc_f + flip(oc_b), gla_norm_w[l], ctx.dtype)
            four_c = fourier_mix(fc, w_four[l])
            mix_c = jnp.concatenate([four_c * jax.nn.silu(fgc), na_c * jax.nn.silu(ngc),
                                     gla_c * jax.nn.silu(ggc)], axis=-1)
            ctx = ctx + gate_c * (mix_c @ w_out[l])
        x = x_new
    return rmsnorm(x, norm_f)
```

```cpp
#include <hip/hip_runtime.h>
#include <hip/hip_bf16.h>
#include <hip/hip_cooperative_groups.h>
#include <cstdio>
namespace cg = cooperative_groups;

typedef unsigned short u16;
using bf16x8 = __attribute__((ext_vector_type(8))) short;
using f32x4 = __attribute__((ext_vector_type(4))) float;
using u32x4 = __attribute__((ext_vector_type(4))) unsigned;

#define NTHREADS 256
#define REP_SUB 100
#define EXTRA_SYNCS 0
#define PROBE_SKIP_EPI 0
#define PROBE_MASK 7
#define LDS_BYTES 81920

constexpr int DM = 1024, NB = 8, SEQ = 2048, DEPTH = 4, CTXL = 256;
constexpr int NX = NB * SEQ;
constexpr int NC = NB * CTXL;
constexpr int NT = NX + NC;
constexpr int DIN = 3232, DINP = 3328;
constexpr int N_NK = 896, N_NV = 1280, N_NG = 1664;
constexpr int PSTR = DIN - 768;
constexpr int C_FIN = 0, C_FG = 256, C_NQ = 512, C_NG = 896;
constexpr int C_GQ = 1280, C_GK = 1472, C_GV = 1664, C_GG = 2048, C_ZF = 2432, C_ZB = 2448;
constexpr int NCH = 36;
constexpr int NUNIT_G = NB * 4 * 2 * NCH;

struct Params {
  const float *x, *c, *ctx, *c_ctx, *w_ada, *b_ada, *norm_w, *w_in, *w_four, *rpb;
  const float *waf, *baf, *wab, *bab, *gnw, *w_out, *norm_f;
  float* out;
  float* mod;
  float* ropecs;
  u16* dft64;
  u16* dftC;
  u16* dftL;
  u16* wtin;
  u16* wtout;
  u16* wtfour;
  u16* hx;
  u16* proj;
  u16* vtx;
  u16* vtc;
  u16* natvx;
  u16* natvc;
  u16* natkx;
  u16* natkc;
  float* ctxw;
  u16* kv;
  float* dec;
  float* gb;
  unsigned* bar;
};

__device__ __forceinline__ int get_tid() { int t = threadIdx.x; asm volatile("" : "+v"(t)); return t; }
typedef __bf16 hbf16x2 __attribute__((ext_vector_type(2)));
typedef float hf32x2 __attribute__((ext_vector_type(2)));
__device__ __forceinline__ u16 f2bf(float f) { return __builtin_bit_cast(u16, (__bf16)f); }
__device__ __forceinline__ float bf2f(u16 h) { return __uint_as_float(((unsigned)h) << 16); }
__device__ __forceinline__ unsigned pack2(float a, float b) { hf32x2 f = {a, b}; return __builtin_bit_cast(unsigned, __builtin_convertvector(f, hbf16x2)); }
__device__ __forceinline__ float silu(float v) { return v / (1.f + __expf(-v)); }
__device__ __forceinline__ float wave_sum(float v) {
#pragma unroll
  for (int o = 32; o > 0; o >>= 1) v += __shfl_xor(v, o);
  return v;
}

#define XB_TMO      128
#define XB_XCNT(j)  (256  + 64 * (j))
#define XB_XSUB(j)  (1280 + 64 * (j))
#define XB_XGEN(j)  (2304 + 64 * (j))
#define XB_TOP      3328
#define XB_TOPGEN   3392
#define XCD_BAR_WORDS 3456
#define XB_SPIN_CAP (1u << 20)
#define LAS __attribute__((address_space(3)))
__device__ __forceinline__ unsigned xb_ld(unsigned* p)              { return __hip_atomic_load(p, __ATOMIC_RELAXED, __HIP_MEMORY_SCOPE_AGENT); }
__device__ __forceinline__ unsigned xb_add(unsigned* p, unsigned v) { return __hip_atomic_fetch_add(p, v, __ATOMIC_RELAXED, __HIP_MEMORY_SCOPE_AGENT); }
__device__ __forceinline__ unsigned xb_xcc_id() { return (unsigned)__builtin_amdgcn_s_getreg((3 << 11) | 20) & 0xFu; }
#define XB_SPIN(cond, bar) do { unsigned _sp = 0; while (cond) { __builtin_amdgcn_s_sleep(1); \
    if ((++_sp & 255u) == 0u) { if (xb_ld(&(bar)[XB_TMO])) break; if (_sp > XB_SPIN_CAP) { atomicAdd(&(bar)[XB_TMO], 1u); break; } } } } while (0)
struct XcdBarrier { unsigned* bar; unsigned x; unsigned nloc, nx, rank; };
__device__ __forceinline__ XcdBarrier xcd_barrier_post(unsigned* bar, unsigned* lds_word) {
  XcdBarrier b; b.bar = bar; b.x = xb_xcc_id(); b.nloc = 0u; b.nx = 0u;
  if (threadIdx.x == 0) *lds_word = xb_add(&bar[XB_XCNT(b.x)], 1u);
  __syncthreads();
  b.rank = *(volatile unsigned*)lds_word;
  __syncthreads();
  return b;
}
__device__ __forceinline__ void xcd_barrier_complete(unsigned* bar, unsigned x, unsigned& nloc, unsigned& nx) {
  const unsigned G = gridDim.x * gridDim.y * gridDim.z;
  unsigned sum, cnt, mine, sp = 0u;
  for (;;) {
    sum = 0u; cnt = 0u; mine = 0u;
#pragma unroll
    for (unsigned j = 0; j < 16; ++j) { const unsigned c = xb_ld(&bar[XB_XCNT(j)]); sum += c; cnt += (c > 0u) ? 1u : 0u; mine = (j == x) ? c : mine; }
    if (sum == G) break;
    __builtin_amdgcn_s_sleep(1);
    if ((++sp & 255u) == 0u) { if (xb_ld(&bar[XB_TMO])) break; if (sp > XB_SPIN_CAP) { atomicAdd(&bar[XB_TMO], 1u); break; } }
  }
  nloc = mine > 0u ? mine : 1u; nx = cnt > 0u ? cnt : 1u;
}
__device__ __forceinline__ void xcd_barrier(XcdBarrier& b) {
  asm volatile("s_waitcnt vmcnt(0)" ::: "memory");
  __syncthreads();
  if (threadIdx.x == 0) {
    unsigned* bar = b.bar;
    __builtin_amdgcn_s_waitcnt(0);
    unsigned nloc = b.nloc, nx = b.nx;
    if (nloc == 0u) { xcd_barrier_complete(bar, b.x, nloc, nx); b.nloc = nloc; b.nx = nx; }
    const unsigned old = xb_add(&bar[XB_XSUB(b.x)], 1u);
    const unsigned gen = old / nloc;
    if (old + 1u == (gen + 1u) * nloc) {
      __builtin_amdgcn_fence(__ATOMIC_RELEASE, "agent");
      asm volatile("s_waitcnt vmcnt(0)" ::: "memory");
      const unsigned og = xb_add(&bar[XB_TOP], 1u);
      const unsigned tg = og / nx;
      if (og + 1u == (tg + 1u) * nx) xb_add(&bar[XB_TOPGEN], 1u);
      else XB_SPIN(xb_ld(&bar[XB_TOPGEN]) == tg, bar);
      __builtin_amdgcn_fence(__ATOMIC_ACQUIRE, "agent");
      xb_add(&bar[XB_XGEN(b.x)], 1u);
      asm volatile("s_waitcnt vmcnt(0)" ::: "memory");
    } else {
      XB_SPIN(xb_ld(&bar[XB_XGEN(b.x)]) == gen, bar);
      __builtin_amdgcn_fence(__ATOMIC_ACQUIRE, "agent");
      asm volatile("s_waitcnt vmcnt(0)" ::: "memory");
    }
  }
  __syncthreads();
}

__device__ __forceinline__ int xcd_vbid(const XcdBarrier& b) {
  unsigned pre = 0;
#pragma unroll
  for (unsigned j = 0; j < 16; ++j) { const unsigned c = xb_ld(&b.bar[XB_XCNT(j)]); pre += (j < b.x) ? c : 0u; }
  return (int)(pre + b.rank);
}

template <int BM, class Epi>
__device__ __forceinline__ void gemm_tile(const u16* __restrict__ A, int lda, const u16* __restrict__ Bt, int ldb,
                                          int K, int m0, int n0, u16* smem, Epi epi) {
  constexpr int MI = BM / 32;
  constexpr int BUF = (BM + 128) * 64;
  const int tid = get_tid(), lane = tid & 63, w = tid >> 6;
  const int wm = w >> 1, wn = w & 1;
  f32x4 acc[MI][4];
#pragma unroll
  for (int i = 0; i < MI; ++i)
#pragma unroll
    for (int j = 0; j < 4; ++j) acc[i][j] = f32x4{0.f, 0.f, 0.f, 0.f};
  const int nk = K >> 6;
  const int srow = lane >> 3;
  const int schunk = (lane & 7) ^ (((w * 8 + srow) >> 1) & 7);
  const u16* ga = A + (size_t)(m0 + w * 8 + srow) * lda + schunk * 8;
  const u16* gb = Bt + (size_t)(n0 + w * 8 + srow) * ldb + schunk * 8;
  const size_t sa32 = (size_t)32 * lda, sb32 = (size_t)32 * ldb;
  const int woff = (w * 8) * 64 + lane * 8;
  const int rsw = ((lane & 15) >> 1) & 7;
  const int c0 = (((lane >> 4)) ^ rsw) * 8, c1 = ((4 + (lane >> 4)) ^ rsw) * 8;
  const int roffA = (wm * (BM / 2) + (lane & 15)) * 64;
  const int roffB = BM * 64 + (wn * 64 + (lane & 15)) * 64;
#define GLDS(gp, lp) __builtin_amdgcn_global_load_lds((const unsigned*)(gp), (unsigned*)(lp), 16, 0, 0)
#define G_ISSUE(buf, koff) { u16* _w = (buf) + woff; \
    _Pragma("unroll") for (int p = 0; p < MI; ++p) GLDS(ga + (koff) + p * sa32, _w + p * 32 * 64); \
    _w += BM * 64; \
    _Pragma("unroll") for (int p = 0; p < 4; ++p) GLDS(gb + (koff) + p * sb32, _w + p * 32 * 64); }
#define RAW_BARRIER() do { asm volatile("s_waitcnt lgkmcnt(0)" ::: "memory"); __builtin_amdgcn_s_barrier(); asm volatile("" ::: "memory"); } while (0)
  __syncthreads();
  G_ISSUE(smem, 0);
  if (nk > 1) G_ISSUE(smem + BUF, 64);
  for (int kt = 0; kt < nk; ++kt) {
    u16* cur = smem + (kt & 1) * BUF;
    if (kt + 1 < nk) {
      if (MI == 4) asm volatile("s_waitcnt vmcnt(8)" ::: "memory"); else asm volatile("s_waitcnt vmcnt(10)" ::: "memory");
    } else asm volatile("s_waitcnt vmcnt(0)" ::: "memory");
    RAW_BARRIER();
    __builtin_amdgcn_sched_barrier(0);
    bf16x8 af[2][MI], bfr[2][4];
#pragma unroll
    for (int i = 0; i < MI; ++i) af[0][i] = *(const bf16x8*)(cur + roffA + i * 16 * 64 + c0);
#pragma unroll
    for (int i = 0; i < 4; ++i) bfr[0][i] = *(const bf16x8*)(cur + roffB + i * 16 * 64 + c0);
#pragma unroll
    for (int i = 0; i < MI; ++i) af[1][i] = *(const bf16x8*)(cur + roffA + i * 16 * 64 + c1);
#pragma unroll
    for (int i = 0; i < 4; ++i) bfr[1][i] = *(const bf16x8*)(cur + roffB + i * 16 * 64 + c1);
    __builtin_amdgcn_sched_barrier(0);
    RAW_BARRIER();
    __builtin_amdgcn_sched_barrier(0);
    if (kt + 2 < nk) G_ISSUE(cur, (size_t)(kt + 2) * 64);
    __builtin_amdgcn_sched_barrier(0);
#pragma unroll
    for (int ks = 0; ks < 2; ++ks)
#pragma unroll
      for (int i = 0; i < MI; ++i)
#pragma unroll
        for (int j = 0; j < 4; ++j)
          acc[i][j] = __builtin_amdgcn_mfma_f32_16x16x32_bf16(bfr[ks][j], af[ks][i], acc[i][j], 0, 0, 0);
  }
#undef RAW_BARRIER
#undef GLDS
#undef G_ISSUE
  __syncthreads();
#pragma unroll
  for (int i = 0; i < MI; ++i)
#pragma unroll
    for (int j = 0; j < 4; ++j) {
      int m = m0 + wm * (BM / 2) + i * 16 + (lane & 15);
      int n = n0 + wn * 64 + j * 16 + (lane >> 4) * 4;
      epi(m, n, acc[i][j]);
    }
}

__device__ void tconv_unit(const float* __restrict__ src, int K, int N, u16* __restrict__ dst, int Npad, int unit, float* tile) {
  const int tid = get_tid();
  const int ntn = Npad >> 6;
  const int nt = unit % ntn, kt = unit / ntn;
  const int k0 = kt * 64, n0 = nt * 64;
  __syncthreads();
#pragma unroll
  for (int p = 0; p < 4; ++p) {
    int i = (tid >> 4) + 16 * p, j = (tid & 15) * 4;
    int n = n0 + j;
    float4 v = make_float4(0.f, 0.f, 0.f, 0.f);
    if (n < N) v = *(const float4*)(src + (size_t)(k0 + i) * N + n);
    tile[i * 65 + j + 0] = v.x; tile[i * 65 + j + 1] = v.y; tile[i * 65 + j + 2] = v.z; tile[i * 65 + j + 3] = v.w;
  }
  __syncthreads();
  {
    int nl = tid >> 2, ks = (tid & 3) * 16;
    unsigned pk[8];
#pragma unroll
    for (int q = 0; q < 8; ++q) pk[q] = pack2(tile[(ks + 2 * q) * 65 + nl], tile[(ks + 2 * q + 1) * 65 + nl]);
    u16* d = dst + (size_t)(n0 + nl) * K + k0 + ks;
    *(uint4*)d = make_uint4(pk[0], pk[1], pk[2], pk[3]);
    *(uint4*)(d + 8) = make_uint4(pk[4], pk[5], pk[6], pk[7]);
  }
}

__device__ void phase0(const Params& P, int bid, int nb, float* sm) {
  const int tid = get_tid();
  float* sv = sm;
  float* red = sm + 9216;
  if (bid < 192) {
    for (int i = tid; i < 9 * 1024; i += NTHREADS) {
      int s = i >> 10, k = i & 1023;
      float v = (s < 8) ? P.c[s * 1024 + k] : P.c_ctx[k];
      sv[i] = silu(v);
    }
    __syncthreads();
    for (int unit = bid; unit < 192; unit += nb) {
      int col0 = unit * 64;
      int l = col0 / 3072, n0 = col0 % 3072;
      int kg = tid >> 6, col = tid & 63;
      float acc[9];
#pragma unroll
      for (int s = 0; s < 9; ++s) acc[s] = 0.f;
      const float* wp = P.w_ada + (size_t)l * 1024 * 3072 + n0 + col;
      for (int k0 = kg * 256; k0 < kg * 256 + 256; k0 += 32) {
        float wv[32];
#pragma unroll
        for (int q = 0; q < 32; ++q) wv[q] = wp[(size_t)(k0 + q) * 3072];
#pragma unroll
        for (int q = 0; q < 32; ++q)
#pragma unroll
          for (int s = 0; s < 9; ++s) acc[s] += sv[s * 1024 + k0 + q] * wv[q];
      }
#pragma unroll
      for (int s = 0; s < 9; ++s) red[(kg * 9 + s) * 64 + col] = acc[s];
      __syncthreads();
      for (int o = tid; o < 576; o += NTHREADS) {
        int s = o >> 6, cc = o & 63;
        float v = red[(0 * 9 + s) * 64 + cc] + red[(1 * 9 + s) * 64 + cc] + red[(2 * 9 + s) * 64 + cc] + red[(3 * 9 + s) * 64 + cc];
        P.mod[((size_t)l * 9 + s) * 3072 + n0 + cc] = v + P.b_ada[l * 3072 + n0 + cc];
      }
      __syncthreads();
    }
  }
  const int gtid = bid * NTHREADS + tid, gsz = nb * NTHREADS;
  const float sL = 0.022097086912079608f;
  for (int i8 = gtid; i8 < 2048 * 512; i8 += gsz) {
    int k = i8 >> 9, t0 = (i8 & 511) * 8;
    unsigned pk[4];
#pragma unroll
    for (int j = 0; j < 4; ++j) {
      float v[2];
#pragma unroll
      for (int e = 0; e < 2; ++e) {
        int tc = t0 + 2 * j + e;
        int t = tc & 2047;
        int m = (k * t) & 2047;
        float a = (float)m * (1.f / 1024.f);
        v[e] = (tc < 2048) ? cospif(a) * sL : -sinpif(a) * sL;
      }
      pk[j] = pack2(v[0], v[1]);
    }
    *(uint4*)(P.dftL + (size_t)k * 4096 + t0) = make_uint4(pk[0], pk[1], pk[2], pk[3]);
  }
  for (int i = gtid; i < 256 * 512; i += gsz) {
    int k = i >> 9, tc = i & 511, t = tc & 255;
    int m = (k * t) & 255;
    float a = (float)m * (1.f / 128.f);
    float v = (tc < 256) ? cospif(a) * 0.0625f : -sinpif(a) * 0.0625f;
    P.dftC[i] = f2bf(v);
  }
  for (int i = gtid; i < 128 * 64; i += gsz) {
    int r = i >> 6, cc = i & 63, j = r & 63;
    int m = (j * cc) & 63;
    float a = (float)m * (1.f / 32.f);
    float v = (r < 64) ? cospif(a) * 0.125f : sinpif(a) * 0.125f;
    P.dft64[i] = f2bf(v);
  }
  for (int i = gtid; i < 2048 * 24; i += gsz) {
    int t = i / 24, f = i % 24;
    int fi = f % 12;
    float pos = (f < 12) ? (float)(t >> 6) : (float)(t & 63);
    float inv = powf(10000.f, -(float)fi / 12.f);
    float ang = pos * inv;
    P.ropecs[2 * i] = cosf(ang);
    P.ropecs[2 * i + 1] = sinf(ang);
  }
}

__device__ void phase1(const Params& P, int l, int bid, int nb, float* sm) {
  const int tid = get_tid(), lane = tid & 63, w = tid >> 6;
  const int u_in = 16 * (DINP / 64), u_out = 16 * 16, u_four = 4 * 4;
  for (int u = bid; u < u_in + u_out + u_four; u += nb) {
    if (u < u_in) tconv_unit(P.w_in + (size_t)l * 1024 * DIN, 1024, DIN, P.wtin, DINP, u, sm);
    else if (u < u_in + u_out) tconv_unit(P.w_out + (size_t)l * 1024 * 1024, 1024, 1024, P.wtout, 1024, u - u_in, sm);
    else tconv_unit(P.w_four + (size_t)l * 256 * 256, 256, 256, P.wtfour, 256, u - u_in - u_out, sm);
  }
  const float* nw = P.norm_w + l * 1024;
  for (int row0 = (bid * 4 + w) * 4; row0 < NT; row0 += nb * 16) {
    const float* src;
    int s;
    if (row0 < NX) { src = (l == 0 ? P.x : P.out) + (size_t)row0 * 1024; s = row0 >> 11; }
    else { src = (l == 0 ? P.ctx : P.ctxw) + (size_t)(row0 - NX) * 1024; s = 8; }
    const float* md = P.mod + ((size_t)l * 9 + s) * 3072;
    float4 v[4][4];
#pragma unroll
    for (int rr = 0; rr < 4; ++rr)
#pragma unroll
      for (int p = 0; p < 4; ++p) v[rr][p] = *(const float4*)(src + rr * 1024 + (p * 64 + lane) * 4);
    float rstd[4];
#pragma unroll
    for (int rr = 0; rr < 4; ++rr) {
      float ss = 0.f;
#pragma unroll
      for (int p = 0; p < 4; ++p) ss += v[rr][p].x * v[rr][p].x + v[rr][p].y * v[rr][p].y + v[rr][p].z * v[rr][p].z + v[rr][p].w * v[rr][p].w;
      ss = wave_sum(ss);
      rstd[rr] = rsqrtf(ss * (1.f / 1024.f) + 1e-6f);
    }
#pragma unroll
    for (int p = 0; p < 4; ++p) {
      int c0 = (p * 64 + lane) * 4;
      float4 wv = *(const float4*)(nw + c0);
      float4 sh = *(const float4*)(md + c0);
      float4 sc = *(const float4*)(md + 1024 + c0);
      const float a0 = wv.x * (1.f + sc.x), a1 = wv.y * (1.f + sc.y), a2 = wv.z * (1.f + sc.z), a3 = wv.w * (1.f + sc.w);
#pragma unroll
      for (int rr = 0; rr < 4; ++rr) {
        float o0 = v[rr][p].x * rstd[rr] * a0 + sh.x;
        float o1 = v[rr][p].y * rstd[rr] * a1 + sh.y;
        float o2 = v[rr][p].z * rstd[rr] * a2 + sh.z;
        float o3 = v[rr][p].w * rstd[rr] * a3 + sh.w;
        *(uint2*)(P.hx + (size_t)(row0 + rr) * 1024 + c0) = make_uint2(pack2(o0, o1), pack2(o2, o3));
      }
    }
  }
}

__device__ void phase2(const Params& P, int bid, int nb, u16* sm, int skip_epi) {
  const int ntn = DINP / 128;
  constexpr int NMT = NT / 192;
  const int total = NMT * ntn;
  for (int L = bid; L < total; L += nb) {
    int mt, nt;
    if (L < NMT * 24) { int band = L / (NMT * 8), q = L % (NMT * 8); mt = q >> 3; nt = band * 8 + (q & 7); }
    else { int q = L - NMT * 24; mt = q >> 1; nt = 24 + (q & 1); }
    u16* const proj = P.proj; u16* const natvx = P.natvx; u16* const natvc = P.natvc; u16* const natkx = P.natkx; u16* const natkc = P.natkc;
    gemm_tile<192>(P.hx, 1024, P.wtin, 1024, 1024, mt * 192, nt * 128, sm, [=](int m, int n, f32x4 v) {
      if (skip_epi && v[0] != 12345.678f) return;
      if (n < DIN) {
        const uint2 pk = make_uint2(pack2(v[0], v[1]), pack2(v[2], v[3]));
        if (n >= N_NK && n < N_NG) {
          if (n < N_NV) {
            int hd = n - N_NK, h = hd >> 6, d = hd & 63;
            if (m < NX) { int b = m >> 11, t = m & 2047; *(uint2*)(natkx + (((size_t)(b * 6 + h)) * 2048 + t) * 64 + d) = pk; }
            else { int mc = m - NX, b = mc >> 8, t = mc & 255; *(uint2*)(natkc + (((size_t)(b * 6 + h)) * 256 + t) * 64 + d) = pk; }
          } else {
            int hd = n - N_NV, h = hd >> 6, d = hd & 63;
            u16* dst;
            if (m < NX) { int b = m >> 11, t = m & 2047; dst = natvx + ((((size_t)(b * 6 + h)) * 256 + (t >> 3)) * 64 + d) * 8 + (t & 7); }
            else { int mc = m - NX, b = mc >> 8, t = mc & 255; dst = natvc + ((((size_t)(b * 6 + h)) * 32 + (t >> 3)) * 64 + d) * 8 + (t & 7); }
#pragma unroll
            for (int q = 0; q < 4; ++q) dst[q * 8] = f2bf(v[q]);
          }
        } else {
          *(uint2*)(proj + (size_t)m * PSTR + (n < N_NK ? n : n - 768)) = pk;
        }
      }
    });
  }
}

struct NaFrag { bf16x8 ka0, ka1, kb0, kb1, v0, v1, v2, v3; };
template <bool LOCAL>
__device__ __forceinline__ void na_load(int kp, const u16* __restrict__ kbase, const u16* __restrict__ vbase, NaFrag& f) {
  const u16* kp0 = kbase + (size_t)(kp * (LOCAL ? 64 : 32)) * 64;
  f.ka0 = *(const bf16x8*)(kp0);
  f.ka1 = *(const bf16x8*)(kp0 + 32);
  f.kb0 = *(const bf16x8*)(kp0 + 4 * 64);
  f.kb1 = *(const bf16x8*)(kp0 + 4 * 64 + 32);
  const u16* vp = vbase + (size_t)(kp * (LOCAL ? 8 : 4)) * 512;
  f.v0 = *(const bf16x8*)(vp);
  f.v1 = *(const bf16x8*)(vp + 128);
  f.v2 = *(const bf16x8*)(vp + 256);
  f.v3 = *(const bf16x8*)(vp + 384);
}
template <bool LOCAL>
__device__ __forceinline__ void na_step(const NaFrag& f, const bf16x8 qf0, const bf16x8 qf1, const float* bp, const int (&bidx)[8],
                                        float& mrun, float& lrun, f32x4 (&o)[4]) {
  constexpr float SC = 0.125f * 1.4426950408889634f;
  {
    const bf16x8 ka0 = f.ka0, ka1 = f.ka1, kb0 = f.kb0, kb1 = f.kb1;
    f32x4 s0 = f32x4{0.f, 0.f, 0.f, 0.f}, s1 = f32x4{0.f, 0.f, 0.f, 0.f};
    s0 = __builtin_amdgcn_mfma_f32_16x16x32_bf16(ka0, qf0, s0, 0, 0, 0);
    s1 = __builtin_amdgcn_mfma_f32_16x16x32_bf16(kb0, qf0, s1, 0, 0, 0);
    s0 = __builtin_amdgcn_mfma_f32_16x16x32_bf16(ka1, qf1, s0, 0, 0, 0);
    s1 = __builtin_amdgcn_mfma_f32_16x16x32_bf16(kb1, qf1, s1, 0, 0, 0);
    float mx;
    if (LOCAL) {
#pragma unroll
      for (int e = 0; e < 4; ++e) { s0[e] = fmaf(s0[e], SC, bp[bidx[e]]); s1[e] = fmaf(s1[e], SC, bp[bidx[4 + e]]); }
    } else {
#pragma unroll
      for (int e = 0; e < 4; ++e) { s0[e] *= SC; s1[e] *= SC; }
    }
    mx = fmaxf(fmaxf(fmaxf(s0[0], s0[1]), fmaxf(s0[2], s0[3])), fmaxf(fmaxf(s1[0], s1[1]), fmaxf(s1[2], s1[3])));
    mx = fmaxf(mx, __shfl_xor(mx, 16));
    mx = fmaxf(mx, __shfl_xor(mx, 32));
    const float mnew = fmaxf(mrun, mx);
    const float alpha = __builtin_amdgcn_exp2f(mrun - mnew);
    float sum = 0.f;
#pragma unroll
    for (int e = 0; e < 4; ++e) {
      float p0 = __builtin_amdgcn_exp2f(s0[e] - mnew), p1 = __builtin_amdgcn_exp2f(s1[e] - mnew);
      s0[e] = p0; s1[e] = p1;
      sum += p0 + p1;
    }
    sum += __shfl_xor(sum, 16);
    sum += __shfl_xor(sum, 32);
    lrun = lrun * alpha + sum;
    mrun = mnew;
    u32x4 pu;
    pu[0] = pack2(s0[0], s0[1]);
    pu[1] = pack2(s0[2], s0[3]);
    pu[2] = pack2(s1[0], s1[1]);
    pu[3] = pack2(s1[2], s1[3]);
    const bf16x8 pfv = __builtin_bit_cast(bf16x8, pu);
#pragma unroll
    for (int dt = 0; dt < 4; ++dt) o[dt] = o[dt] * alpha;
    o[0] = __builtin_amdgcn_mfma_f32_16x16x32_bf16(f.v0, pfv, o[0], 0, 0, 0);
    o[1] = __builtin_amdgcn_mfma_f32_16x16x32_bf16(f.v1, pfv, o[1], 0, 0, 0);
    o[2] = __builtin_amdgcn_mfma_f32_16x16x32_bf16(f.v2, pfv, o[2], 0, 0, 0);
    o[3] = __builtin_amdgcn_mfma_f32_16x16x32_bf16(f.v3, pfv, o[3], 0, 0, 0);
  }
}

__device__ __forceinline__ int na_kswz(int key) { return (((key >> 3) & 3) << 1) | ((key >> 1) & 1); }
template <bool LAT>
__device__ __forceinline__ void na_unit(const Params& P, int l, int unit, float* sm) {
  const int tid = get_tid(), lane = tid & 63, w = __builtin_amdgcn_readfirstlane(tid >> 6);
  const int qi = lane & 15, g = lane >> 4;
  int b, h, r = 0, c0 = 0, m;
  float* srpb = sm;
  u16* ring = (u16*)(sm + 512);
  constexpr int KL = 0, VL = 4096, KC = LAT ? 8192 : 0, VC = LAT ? 10240 : 2048, SLOT = LAT ? 12288 : 4096;
  constexpr int NI = LAT ? 6 : 2;
  __syncthreads();
  if (LAT) {
    r = unit & 31; h = (unit >> 5) % 6; b = unit / 192;
    c0 = 16 * w;
    m = b * 2048 + r * 64 + c0 + qi;
    for (int i = tid; i < 15 * 32; i += NTHREADS) { int rw = i >> 5, cc = i & 31; srpb[i] = (cc < 31) ? P.rpb[((size_t)l * 6 + h) * 465 + rw * 31 + cc] * 1.4426950408889634f : -1e30f; }
  } else {
    int qt = unit & 3; h = (unit >> 2) % 6; b = unit / 24;
    m = NX + b * 256 + (qt * 4 + w) * 16 + qi;
  }
  const u16* proj = P.proj;
  const bf16x8 qf0 = *(const bf16x8*)(proj + (size_t)m * PSTR + C_NQ + h * 64 + g * 8);
  const bf16x8 qf1 = *(const bf16x8*)(proj + (size_t)m * PSTR + C_NQ + h * 64 + 32 + g * 8);
  const int rs = LAT ? min(max(r - 4, 0), 24) : 0;
  const int ws = LAT ? min(max(c0 - 8, 0), 32) : 0;
  const int qc = c0 + qi;
  const int cs = min(max(qc - 8, 0), 48);
  const int dkey = lane >> 3, dslot = lane & 7;
  const size_t bh = (size_t)(b * 6 + h);
  const u16* gKL0 = P.natkx + (bh * 2048 + rs * 64 + w * 8 + dkey) * 64 + ((dslot ^ na_kswz(w * 8 + dkey)) * 8);
  const u16* gKL1 = P.natkx + (bh * 2048 + rs * 64 + 32 + w * 8 + dkey) * 64 + ((dslot ^ na_kswz(32 + w * 8 + dkey)) * 8);
  const u16* gVL0 = P.natvx + (bh * 256 + rs * 8) * 512 + w * 512 + lane * 8;
  const u16* gVL1 = gVL0 + 4 * 512;
  const u16* gKC = P.natkc + (bh * 256 + w * 8 + dkey) * 64 + ((dslot ^ na_kswz(w * 8 + dkey)) * 8);
  const u16* gVC = P.natvc + (bh * 32) * 512 + w * 512 + lane * 8;
  const int lseg = w * 512 + lane * 8;
#define GLDS(gp, lp) __builtin_amdgcn_global_load_lds((const unsigned*)(gp), (unsigned*)(lp), 16, 0, 0)
  const u16 *pKL0 = gKL0, *pKL1 = gKL1, *pVL0 = gVL0, *pVL1 = gVL1, *pKC = gKC, *pVC = gVC;
#define NA_ISSUE(slot) { u16* _s = ring + (slot) * SLOT; \
    if (LAT) { GLDS(pKL0, _s + KL + lseg); GLDS(pKL1, _s + KL + 2048 + lseg); GLDS(pVL0, _s + VL + lseg); GLDS(pVL1, _s + VL + 2048 + lseg); \
               pKL0 += 64 * 64; pKL1 += 64 * 64; pVL0 += 8 * 512; pVL1 += 8 * 512; } \
    GLDS(pKC, _s + KC + lseg); GLDS(pVC, _s + VC + lseg); pKC += 32 * 64; pVC += 4 * 512; }
#define RAW_BARRIER() do { asm volatile("s_waitcnt lgkmcnt(0)" ::: "memory"); __builtin_amdgcn_s_barrier(); asm volatile("" ::: "memory"); } while (0)
  const int prow = (qi >> 2) * 8 + (qi & 3);
  const int fL = na_kswz(ws + prow), fC = na_kswz(prow);
  const int rKL = KL + (ws + prow) * 64, rKC = KC + prow * 64;
  const int cL0 = ((g) ^ fL) * 8, cL1 = ((4 + g) ^ fL) * 8, cC0 = ((g) ^ fC) * 8, cC1 = ((4 + g) ^ fC) * 8;
  const int rVL = VL + (((ws >> 3) + g) * 64 + qi) * 8, rVC = VC + (g * 64 + qi) * 8;
  int bidx[8];
#pragma unroll
  for (int j = 0; j < 8; ++j) {
    int kc = ws + g * 8 + j;
    bool ok = (kc >= cs) && (kc < cs + 16);
    bidx[j] = ok ? min(max(kc - qc + 15, 0), 30) : 31;
  }
  float mL = -1e30f, lL = 0.f, mC = -1e30f, lC = 0.f;
  f32x4 oL[4], o[4];
#pragma unroll
  for (int dt = 0; dt < 4; ++dt) { oL[dt] = f32x4{0.f, 0.f, 0.f, 0.f}; o[dt] = f32x4{0.f, 0.f, 0.f, 0.f}; }
  asm volatile("s_waitcnt vmcnt(0)" ::: "memory");
  NA_ISSUE(0); NA_ISSUE(1); NA_ISSUE(2);
  int slot = 0;
#pragma unroll 1
  for (int kp = 0; kp < 8; ++kp) {
    if (kp <= 5) { if (LAT) asm volatile("s_waitcnt vmcnt(12)" ::: "memory"); else asm volatile("s_waitcnt vmcnt(4)" ::: "memory"); }
    else if (kp == 6) { if (LAT) asm volatile("s_waitcnt vmcnt(6)" ::: "memory"); else asm volatile("s_waitcnt vmcnt(2)" ::: "memory"); }
    else asm volatile("s_waitcnt vmcnt(0)" ::: "memory");
    RAW_BARRIER();
    __builtin_amdgcn_sched_barrier(0);
    const u16* sl = ring + slot * SLOT;
    NaFrag FL, FC;
    if (LAT) {
      FL.ka0 = *(const bf16x8*)(sl + rKL + cL0); FL.ka1 = *(const bf16x8*)(sl + rKL + cL1);
      FL.kb0 = *(const bf16x8*)(sl + rKL + 4 * 64 + cL0); FL.kb1 = *(const bf16x8*)(sl + rKL + 4 * 64 + cL1);
      FL.v0 = *(const bf16x8*)(sl + rVL); FL.v1 = *(const bf16x8*)(sl + rVL + 128); FL.v2 = *(const bf16x8*)(sl + rVL + 256); FL.v3 = *(const bf16x8*)(sl + rVL + 384);
    }
    FC.ka0 = *(const bf16x8*)(sl + rKC + cC0); FC.ka1 = *(const bf16x8*)(sl + rKC + cC1);
    FC.kb0 = *(const bf16x8*)(sl + rKC + 4 * 64 + cC0); FC.kb1 = *(const bf16x8*)(sl + rKC + 4 * 64 + cC1);
    FC.v0 = *(const bf16x8*)(sl + rVC); FC.v1 = *(const bf16x8*)(sl + rVC + 128); FC.v2 = *(const bf16x8*)(sl + rVC + 256); FC.v3 = *(const bf16x8*)(sl + rVC + 384);
    __builtin_amdgcn_sched_barrier(0);
    RAW_BARRIER();
    __builtin_amdgcn_sched_barrier(0);
    if (kp + 3 < 8) NA_ISSUE(slot);
    slot = (slot == 2) ? 0 : slot + 1;
    __builtin_amdgcn_sched_barrier(0);
    if (LAT) na_step<true>(FL, qf0, qf1, srpb + (rs + kp - r + 7) * 32, bidx, mL, lL, oL);
    na_step<false>(FC, qf0, qf1, srpb, bidx, mC, lC, o);
  }
#undef GLDS
#undef NA_ISSUE
#undef RAW_BARRIER
  float lrun = lC;
  if (LAT) {
    const float mm = fmaxf(mL, mC);
    const float aL = __builtin_amdgcn_exp2f(mL - mm), aC = __builtin_amdgcn_exp2f(mC - mm);
    lrun = lL * aL + lC * aC;
#pragma unroll
    for (int dt = 0; dt < 4; ++dt) o[dt] = oL[dt] * aL + o[dt] * aC;
  }
  const float rinv = 1.f / lrun;
#pragma unroll
  for (int dt = 0; dt < 4; ++dt) {
    int d = h * 64 + dt * 16 + g * 4;
    uint2 gg = *(const uint2*)(proj + (size_t)m * PSTR + C_NG + d);
    float g0 = bf2f((u16)(gg.x & 0xffff)), g1 = bf2f((u16)(gg.x >> 16)), g2 = bf2f((u16)(gg.y & 0xffff)), g3 = bf2f((u16)(gg.y >> 16));
    float o0 = o[dt][0] * rinv * silu(g0), o1 = o[dt][1] * rinv * silu(g1), o2 = o[dt][2] * rinv * silu(g2), o3 = o[dt][3] * rinv * silu(g3);
    *(uint2*)(P.hx + (size_t)m * 1024 + 256 + d) = make_uint2(pack2(o0, o1), pack2(o2, o3));
  }
}

__device__ __forceinline__ int gla_tok_row(int b, int c, int tk) {
  return (c < 4) ? (NX + b * 256 + c * 64 + tk) : (b * 2048 + (c - 4) * 64 + tk);
}
__device__ __forceinline__ void unpack8(const uint4 v, float* f) {
  f[0] = __uint_as_float(v.x << 16); f[1] = __uint_as_float(v.x & 0xffff0000u);
  f[2] = __uint_as_float(v.y << 16); f[3] = __uint_as_float(v.y & 0xffff0000u);
  f[4] = __uint_as_float(v.z << 16); f[5] = __uint_as_float(v.z & 0xffff0000u);
  f[6] = __uint_as_float(v.w << 16); f[7] = __uint_as_float(v.w & 0xffff0000u);
}
__device__ __forceinline__ void load24(const u16* p, float* f) {
  uint4 a = *(const uint4*)(p), b = *(const uint4*)(p + 8), c = *(const uint4*)(p + 16);
  unpack8(a, f); unpack8(b, f + 8); unpack8(c, f + 16);
}
template <int MODE>
__device__ __forceinline__ void gla_prep(const Params& P, int l, int b, int h, int c, int dir, u16* s0, u16* s1, float* decp, float* gla_stage, float* bstore) {
  const int tid = get_tid(), lane = tid & 63, w = __builtin_amdgcn_readfirstlane(tid >> 6);
  const bool lat = c >= 4;
  const int row = gla_tok_row(b, c, lane);
  const u16* prow = P.proj + (size_t)row * PSTR;
  const int half = w >> 1, hi = w & 1;
  float cs[24];
  if (lat) {
    const float* cp = P.ropecs + ((size_t)(row & 2047) * 24 + half * 12) * 2;
#pragma unroll
    for (int q = 0; q < 6; ++q) {
      float4 v = *(const float4*)(cp + 4 * q);
      cs[4 * q] = v.x; cs[4 * q + 1] = v.y; cs[4 * q + 2] = v.z; cs[4 * q + 3] = v.w;
    }
  } else {
#pragma unroll
    for (int q = 0; q < 12; ++q) { cs[2 * q] = 1.f; cs[2 * q + 1] = 0.f; }
  }
  uint4 kraw0 = *(const uint4*)(prow + C_GK + h * 48 + half * 24), kraw1 = *(const uint4*)(prow + C_GK + h * 48 + half * 24 + 8), kraw2 = *(const uint4*)(prow + C_GK + h * 48 + half * 24 + 16);
  uint4 qraw0 = kraw0, qraw1 = kraw1, qraw2 = kraw2;
  if (MODE == 1) { qraw0 = *(const uint4*)(prow + C_GQ + h * 48 + half * 24); qraw1 = *(const uint4*)(prow + C_GQ + h * 48 + half * 24 + 8); qraw2 = *(const uint4*)(prow + C_GQ + h * 48 + half * 24 + 16); }
  float bb[12];
  float* const bmine = bstore + lane * 48 + 12 * w;
  if (MODE == 0) {
  const float* wag = (dir ? P.wab : P.waf) + (size_t)l * 16 * 192 + h * 48;
  const float* ba = (dir ? P.bab : P.baf) + (size_t)l * 192 + h * 48 + 12 * w;
  float* swa = gla_stage;
  float* sz = gla_stage + 768;
  __syncthreads();
  for (int i = tid; i < 768; i += NTHREADS) { int rr = i / 48, kk = i % 48; swa[i] = wag[rr * 192 + kk]; }
  {
    int tk = tid >> 2, q = tid & 3;
    uint2 zz = *(const uint2*)(P.proj + (size_t)gla_tok_row(b, c, tk) * PSTR + C_ZF + dir * 16 + q * 4);
    float* d = sz + tk * 17 + q * 4;
    d[0] = __uint_as_float(zz.x << 16); d[1] = __uint_as_float(zz.x & 0xffff0000u);
    d[2] = __uint_as_float(zz.y << 16); d[3] = __uint_as_float(zz.y & 0xffff0000u);
  }
  __syncthreads();
#pragma unroll
  for (int j = 0; j < 12; ++j) bb[j] = ba[j];
#pragma unroll 1
  for (int rr = 0; rr < 16; ++rr) {
    const float zv = sz[lane * 17 + rr];
    const float4 w0 = *(const float4*)(swa + rr * 48 + 12 * w);
    const float4 w1 = *(const float4*)(swa + rr * 48 + 12 * w + 4);
    const float4 w2 = *(const float4*)(swa + rr * 48 + 12 * w + 8);
    bb[0] += zv * w0.x; bb[1] += zv * w0.y; bb[2] += zv * w0.z; bb[3] += zv * w0.w;
    bb[4] += zv * w1.x; bb[5] += zv * w1.y; bb[6] += zv * w1.z; bb[7] += zv * w1.w;
    bb[8] += zv * w2.x; bb[9] += zv * w2.y; bb[10] += zv * w2.z; bb[11] += zv * w2.w;
  }
#pragma unroll
  for (int j = 0; j < 12; ++j) {
    float gsum = bb[j];
    float ls = fminf(gsum, 0.f) - __logf(1.f + __expf(-fabsf(gsum)));
    bb[j] = ls * (1.f / 16.f);
  }
#pragma unroll
  for (int off = 1; off < 64; off <<= 1) {
#pragma unroll
    for (int j = 0; j < 12; ++j) {
      float t = dir ? __shfl_down(bb[j], off) : __shfl_up(bb[j], off);
      bool ok = dir ? (lane + off < 64) : (lane >= off);
      bb[j] += ok ? t : 0.f;
    }
  }
  *(float4*)(bmine) = make_float4(bb[0], bb[1], bb[2], bb[3]);
  *(float4*)(bmine + 4) = make_float4(bb[4], bb[5], bb[6], bb[7]);
  *(float4*)(bmine + 8) = make_float4(bb[8], bb[9], bb[10], bb[11]);
  } else {
    const float4 b0 = *(const float4*)(bmine), b1 = *(const float4*)(bmine + 4), b2 = *(const float4*)(bmine + 8);
    bb[0] = b0.x; bb[1] = b0.y; bb[2] = b0.z; bb[3] = b0.w; bb[4] = b1.x; bb[5] = b1.y; bb[6] = b1.z; bb[7] = b1.w;
    bb[8] = b2.x; bb[9] = b2.y; bb[10] = b2.z; bb[11] = b2.w;
  }
  float kr[24];
  unpack8(kraw0, kr); unpack8(kraw1, kr + 8); unpack8(kraw2, kr + 16);
  if (MODE == 0) {
    unsigned pk[6];
    float bend[12];
#pragma unroll
    for (int j = 0; j < 12; ++j) bend[j] = __shfl(bb[j], dir ? 0 : 63);
#pragma unroll
    for (int j = 0; j < 12; ++j) {
      float c0 = cs[2 * j], s0v = cs[2 * j + 1];
      float rot = hi ? (kr[j] * s0v + kr[12 + j] * c0) : (kr[j] * c0 - kr[12 + j] * s0v);
      float val = rot * __expf(bend[j] - bb[j]);
      s0[(12 * w + j) * 72 + lane] = f2bf(val);
    }
    if (lane == 0) {
#pragma unroll
      for (int j = 0; j < 12; ++j) decp[12 * w + j] = __expf(bend[j]);
    }
    (void)pk;
  } else {
    float qr[24];
    unpack8(qraw0, qr); unpack8(qraw1, qr + 8); unpack8(qraw2, qr + 16);
    unsigned pq[6], pkk[6];
#pragma unroll
    for (int j2 = 0; j2 < 6; ++j2) {
      float vq[2], vk[2];
#pragma unroll
      for (int e = 0; e < 2; ++e) {
        int j = 2 * j2 + e;
        float c0 = cs[2 * j], s0v = cs[2 * j + 1];
        float rq = hi ? (qr[j] * s0v + qr[12 + j] * c0) : (qr[j] * c0 - qr[12 + j] * s0v);
        float rk = hi ? (kr[j] * s0v + kr[12 + j] * c0) : (kr[j] * c0 - kr[12 + j] * s0v);
        float eb = __expf(bb[j]);
        vq[e] = rq * 0.14433756729740643f * eb;
        vk[e] = rk / eb;
      }
      pq[j2] = pack2(vq[0], vq[1]);
      pkk[j2] = pack2(vk[0], vk[1]);
    }
    u16* dq = s0 + lane * 72 + 12 * w;
    u16* dk = s1 + lane * 72 + 12 * w;
    *(uint2*)(dq) = make_uint2(pq[0], pq[1]); *(uint2*)(dq + 4) = make_uint2(pq[2], pq[3]); *(uint2*)(dq + 8) = make_uint2(pq[4], pq[5]);
    *(uint2*)(dk) = make_uint2(pkk[0], pkk[1]); *(uint2*)(dk + 4) = make_uint2(pkk[2], pkk[3]); *(uint2*)(dk + 8) = make_uint2(pkk[4], pkk[5]);
  }
}
__device__ __forceinline__ void gla_load_vT(const Params& P, int b, int h, int c, u16* svT) {
  const int tid = get_tid(), lane = tid & 63, w = __builtin_amdgcn_readfirstlane(tid >> 6);
  const u16* p = P.proj + (size_t)gla_tok_row(b, c, lane) * PSTR + C_GV + h * 96 + 24 * w;
  uint4 a = *(const uint4*)(p), bq = *(const uint4*)(p + 8), cq = *(const uint4*)(p + 16);
  unsigned wv[12] = {a.x, a.y, a.z, a.w, bq.x, bq.y, bq.z, bq.w, cq.x, cq.y, cq.z, cq.w};
#pragma unroll
  for (int q = 0; q < 12; ++q) {
    svT[(24 * w + 2 * q) * 72 + lane] = (u16)(wv[q] & 0xffffu);
    svT[(24 * w + 2 * q + 1) * 72 + lane] = (u16)(wv[q] >> 16);
  }
}

__device__ void gla_g1_unit(const Params& P, int l, int unit, float* sm) {
  const int tid = get_tid(), lane = tid & 63, w = __builtin_amdgcn_readfirstlane(tid >> 6), g = lane >> 4, li = lane & 15;
  int chain = unit / NCH, n = unit % NCH;
  int b = chain >> 3, h = (chain >> 1) & 3, dir = chain & 1;
  int c = (dir == 0) ? n : (n < 4 ? 3 - n : 39 - n);
  u16* svT = (u16*)sm;
  u16* skT = svT + 96 * 72;
  __syncthreads();
  gla_load_vT(P, b, h, c, svT);
  gla_prep<0>(P, l, b, h, c, dir, skT, nullptr, P.dec + (size_t)unit * 48, sm + 8192, P.gb + (size_t)unit * 3072);
  __syncthreads();
  u16* kvp = P.kv + (size_t)unit * 4608;
  for (int vt = w; vt < 6; vt += 4) {
    f32x4 acc[3];
#pragma unroll
    for (int j = 0; j < 3; ++j) acc[j] = f32x4{0.f, 0.f, 0.f, 0.f};
#pragma unroll
    for (int ks = 0; ks < 2; ++ks) {
      bf16x8 af = *(const bf16x8*)(svT + (vt * 16 + li) * 72 + ks * 32 + g * 8);
#pragma unroll
      for (int j = 0; j < 3; ++j) {
        bf16x8 bfv = *(const bf16x8*)(skT + (j * 16 + li) * 72 + ks * 32 + g * 8);
        acc[j] = __builtin_amdgcn_mfma_f32_16x16x32_bf16(af, bfv, acc[j], 0, 0, 0);
      }
    }
#pragma unroll
    for (int j = 0; j < 3; ++j)
#pragma unroll
      for (int e = 0; e < 4; ++e) kvp[(vt * 16 + g * 4 + e) * 48 + j * 16 + li] = f2bf(acc[j][e]);
  }
}

__device__ void gla_g2(const Params& P, int idx) {
  int chain = idx / 4608, e = idx % 4608, kk = e % 48;
  u16* kp = P.kv + (size_t)chain * NCH * 4608 + e;
  const float* dp = P.dec + (size_t)chain * NCH * 48 + kk;
  float kvv[NCH], dd[NCH];
#pragma unroll
  for (int n = 0; n < NCH; ++n) { kvv[n] = bf2f(kp[(size_t)n * 4608]); dd[n] = dp[n * 48]; }
  float S = 0.f;
#pragma unroll
  for (int n = 0; n < NCH; ++n) {
    kp[(size_t)n * 4608] = f2bf(S);
    S = dd[n] * S + kvv[n];
  }
}

__device__ void gla_g3_unit(const Params& P, int l, int unit, float* sm) {
  const int tid = get_tid(), lane = tid & 63, w = __builtin_amdgcn_readfirstlane(tid >> 6), g = lane >> 4, li = lane & 15;
  int c = unit % NCH, h = (unit / NCH) & 3, b = unit / (NCH * 4);
  u16* svT = (u16*)sm;
  u16* sqd = svT + 96 * 72;
  u16* skd = sqd + 64 * 72;
  __syncthreads();
  gla_load_vT(P, b, h, c, svT);
  for (int i = tid; i < 64 * 8; i += NTHREADS) {
    int r = i >> 3, q = i & 7;
    *(unsigned*)(sqd + r * 72 + 48 + 2 * q) = 0u;
    *(unsigned*)(skd + r * 72 + 48 + 2 * q) = 0u;
  }
  f32x4 o[6];
#pragma unroll
  for (int vt = 0; vt < 6; ++vt) o[vt] = f32x4{0.f, 0.f, 0.f, 0.f};
  const int tkq = 16 * w + li;
#pragma unroll 1
  for (int dir = 0; dir < 2; ++dir) {
    const int chain = (b * 4 + h) * 2 + dir;
    const int n = (dir == 0) ? c : (c < 4 ? 3 - c : 39 - c);
    const u16* Sp = P.kv + ((size_t)chain * NCH + n) * 4608;
    bf16x8 sfa[6], sfb[6];
#pragma unroll
    for (int vt = 0; vt < 6; ++vt) {
      const u16* sp = Sp + (vt * 16 + li) * 48 + g * 8;
      sfa[vt] = *(const bf16x8*)(sp);
      u32x4 zz = u32x4{0u, 0u, 0u, 0u};
      sfb[vt] = __builtin_bit_cast(bf16x8, zz);
      if (g < 2) sfb[vt] = *(const bf16x8*)(sp + 32);
    }
    gla_prep<1>(P, l, b, h, c, dir, sqd, skd, nullptr, sm + 8192, P.gb + ((size_t)chain * NCH + n) * 3072);
    __syncthreads();
    const bf16x8 q0 = *(const bf16x8*)(sqd + tkq * 72 + g * 8);
    const bf16x8 q1 = *(const bf16x8*)(sqd + tkq * 72 + 32 + g * 8);
    f32x4 st[4];
#pragma unroll
    for (int t = 0; t < 4; ++t) {
      f32x4 a = f32x4{0.f, 0.f, 0.f, 0.f};
      const bool need = dir ? (t >= w) : (t <= w);
      if (need) {
        bf16x8 k0 = *(const bf16x8*)(skd + (t * 16 + li) * 72 + g * 8);
        bf16x8 k1 = *(const bf16x8*)(skd + (t * 16 + li) * 72 + 32 + g * 8);
        a = __builtin_amdgcn_mfma_f32_16x16x32_bf16(k0, q0, a, 0, 0, 0);
        a = __builtin_amdgcn_mfma_f32_16x16x32_bf16(k1, q1, a, 0, 0, 0);
#pragma unroll
        for (int e = 0; e < 4; ++e) {
          int sidx = t * 16 + g * 4 + e;
          bool valid = dir ? (sidx >= tkq) : (sidx <= tkq);
          a[e] = valid ? a[e] : 0.f;
        }
      }
      st[t] = a;
    }
#pragma unroll
    for (int pr = 0; pr < 2; ++pr) {
      u32x4 pu;
      pu[0] = pack2(st[2 * pr][0], st[2 * pr][1]);
      pu[1] = pack2(st[2 * pr][2], st[2 * pr][3]);
      pu[2] = pack2(st[2 * pr + 1][0], st[2 * pr + 1][1]);
      pu[3] = pack2(st[2 * pr + 1][2], st[2 * pr + 1][3]);
      const bf16x8 pfv = __builtin_bit_cast(bf16x8, pu);
#pragma unroll
      for (int vt = 0; vt < 6; ++vt) {
        const u16* vp = svT + (vt * 16 + li) * 72 + pr * 32 + g * 4;
        uint2 va = *(const uint2*)(vp);
        uint2 vb = *(const uint2*)(vp + 16);
        u32x4 vu; vu[0] = va.x; vu[1] = va.y; vu[2] = vb.x; vu[3] = vb.y;
        o[vt] = __builtin_amdgcn_mfma_f32_16x16x32_bf16(__builtin_bit_cast(bf16x8, vu), pfv, o[vt], 0, 0, 0);
      }
    }
#pragma unroll
    for (int vt = 0; vt < 6; ++vt) {
      o[vt] = __builtin_amdgcn_mfma_f32_16x16x32_bf16(sfa[vt], q0, o[vt], 0, 0, 0);
      o[vt] = __builtin_amdgcn_mfma_f32_16x16x32_bf16(sfb[vt], q1, o[vt], 0, 0, 0);
    }
    __syncthreads();
  }
  float ss = 0.f;
#pragma unroll
  for (int vt = 0; vt < 6; ++vt)
#pragma unroll
    for (int e = 0; e < 4; ++e) ss += o[vt][e] * o[vt][e];
  ss += __shfl_xor(ss, 16);
  ss += __shfl_xor(ss, 32);
  const float rstd = rsqrtf(ss * (1.f / 96.f) + 1e-6f);
  const int row = gla_tok_row(b, c, tkq);
  const float* gw = P.gnw + l * 96;
#pragma unroll
  for (int vt = 0; vt < 6; ++vt) {
    int vv = vt * 16 + g * 4;
    uint2 gg = *(const uint2*)(P.proj + (size_t)row * PSTR + C_GG + h * 96 + vv);
    float4 gwv = *(const float4*)(gw + vv);
    float g0 = bf2f((u16)(gg.x & 0xffff)), g1 = bf2f((u16)(gg.x >> 16)), g2 = bf2f((u16)(gg.y & 0xffff)), g3 = bf2f((u16)(gg.y >> 16));
    float o0 = o[vt][0] * rstd * gwv.x * silu(g0), o1 = o[vt][1] * rstd * gwv.y * silu(g1);
    float o2 = o[vt][2] * rstd * gwv.z * silu(g2), o3 = o[vt][3] * rstd * gwv.w * silu(g3);
    *(uint2*)(P.hx + (size_t)row * 1024 + 640 + h * 96 + vv) = make_uint2(pack2(o0, o1), pack2(o2, o3));
  }
}

constexpr int P4_NFX = NB * 16 * 2;
constexpr int NA_PER_IDLE = 2;
__device__ __forceinline__ int na_total(bool last) { return NB * 32 * 6 + (last ? 0 : NB * 6 * 4); }
__device__ __forceinline__ int p4_nfc(bool last) { return last ? 0 : NB * 2 * 2; }
__device__ __forceinline__ int na_p4_count(int nb, bool last) {
  const int n_idle = nb > P4_NFX ? nb - P4_NFX : 0, nfc = p4_nfc(last);
  const int a = n_idle < nfc ? n_idle : nfc;
  int c = (NA_PER_IDLE - 1) * a + NA_PER_IDLE * (n_idle - a);
  const int tot = na_total(last);
  return c < tot ? c : tot;
}
__device__ __forceinline__ void na_any(const Params& P, int l, int id, float* sm) {
  const int n_na = NB * 32 * 6;
  if (id < n_na) na_unit<true>(P, l, id, sm); else na_unit<false>(P, l, id - n_na, sm);
}

__device__ void phase3(const Params& P, int l, int bid, int nb, float* sm, int mask) {
  const bool last = (l == DEPTH - 1);
  const int n_cut = na_total(last) - na_p4_count(nb, last);
  const int n_g1 = NUNIT_G;
  const int n_f1 = (last ? (NX + 191) / 192 : NT / 192) * 4;
  const int total = n_cut + n_g1 + n_f1;
  for (int u = bid; u < total; u += nb) {
    int v = u;
    if (v < n_cut) { if (mask & 1) na_any(P, l, v, sm); continue; }
    v -= n_cut;
    if (v < n_g1) { if (mask & 2) gla_g1_unit(P, l, v, sm); continue; }
    v -= n_g1;
    if (mask & 4) {
      int mt = v >> 2, gq = v & 3;
      u16* const vtx = P.vtx; u16* const vtc = P.vtc;
      gemm_tile<192>(P.proj + C_FIN + gq * 64, PSTR, P.dft64, 64, 64, mt * 192, 0, (u16*)sm, [=](int m, int n, f32x4 val) {
        int part = n >> 6, j = n & 63;
        if (m < NX) {
          int b = m >> 11, t = m & 2047;
          u16* d = vtx + ((size_t)(b * 256 + gq * 64 + j)) * 4096 + part * 2048 + t;
#pragma unroll
          for (int q = 0; q < 4; ++q) d[(size_t)q * 4096] = f2bf(val[q]);
        } else {
          int mc = m - NX, b = mc >> 8, t = mc & 255;
          u16* d = vtc + ((size_t)(b * 256 + gq * 64 + j)) * 512 + part * 256 + t;
#pragma unroll
          for (int q = 0; q < 4; ++q) d[(size_t)q * 512] = f2bf(val[q]);
        }
      });
    }
  }
}

__device__ void phase4(const Params& P, int l, int bid, int nb, float* sm, int noscan) {
  const bool last = (l == DEPTH - 1);
  const int n_fx = P4_NFX;
  const int n_fc = p4_nfc(last);
  const int n_sc = (64 * 4608) / NTHREADS;
  const int n_idle = nb > n_fx ? nb - n_fx : 0;
  u16* const proj = P.proj;
  for (int v = bid; v < n_fx; v += nb) {
    int b = v >> 5, mt = (v >> 1) & 15, nt = v & 1;
    gemm_tile<128>(P.dftL, 4096, P.vtx + (size_t)b * 256 * 4096, 4096, 4096, mt * 128, nt * 128, (u16*)sm, [=](int m, int n, f32x4 val) {
      *(uint2*)(proj + (size_t)(b * 2048 + m) * PSTR + C_FIN + n) = make_uint2(pack2(val[0], val[1]), pack2(val[2], val[3]));
    });
  }
  {
    const int j = bid - n_fx;
    const int jj = (n_idle > 0) ? j : bid, jstride = (n_idle > 0) ? n_idle : nb;
    if (n_idle == 0 || j >= 0) {
      for (int v = jj; v < n_fc; v += jstride) {
        int b = v >> 2, mt = (v >> 1) & 1, nt = v & 1;
        gemm_tile<128>(P.dftC, 512, P.vtc + (size_t)b * 256 * 512, 512, 512, mt * 128, nt * 128, (u16*)sm, [=](int m, int n, f32x4 val) {
          *(uint2*)(proj + (size_t)(NX + b * 256 + m) * PSTR + C_FIN + n) = make_uint2(pack2(val[0], val[1]), pack2(val[2], val[3]));
        });
      }
    }
    if (!noscan && j >= 0) {
      const int tot = na_total(last), cut = tot - na_p4_count(nb, last);
      const int a = n_idle < n_fc ? n_idle : n_fc;
      const int nmine = (j < a) ? NA_PER_IDLE - 1 : NA_PER_IDLE;
      const int base = cut + ((j < a) ? (NA_PER_IDLE - 1) * j : (NA_PER_IDLE - 1) * a + NA_PER_IDLE * (j - a));
      for (int q = 0; q < nmine; ++q) { const int id = base + q; if (id < tot) na_any(P, l, id, sm); }
    }
  }
  if (!noscan) for (int v = bid; v < n_sc; v += nb) gla_g2(P, v * NTHREADS + get_tid());
}

__device__ void phase5(const Params& P, int l, int bid, int nb, float* sm) {
  const bool last = (l == DEPTH - 1);
  const int n_g3 = NB * 4 * NCH;
  const int n_w4 = (last ? (NX + 191) / 192 : NT / 192) * 2;
  const int total = n_g3 + n_w4;
  for (int u = bid; u < total; u += nb) {
    int v = u;
    if (v < n_g3) {
      int c = v % NCH;
      if (last && c < 4) continue;
      gla_g3_unit(P, l, v, sm);
      continue;
    }
    v -= n_g3;
    int mt = v >> 1, nt = v & 1;
    u16* const proj = P.proj; u16* const mix = P.hx;
    gemm_tile<192>(P.proj + C_FIN, PSTR, P.wtfour, 256, 256, mt * 192, nt * 128, (u16*)sm, [=](int m, int n, f32x4 val) {
      if (last && m >= NX) return;
      uint2 gg = *(const uint2*)(proj + (size_t)m * PSTR + C_FG + n);
      float g0 = bf2f((u16)(gg.x & 0xffff)), g1 = bf2f((u16)(gg.x >> 16)), g2 = bf2f((u16)(gg.y & 0xffff)), g3 = bf2f((u16)(gg.y >> 16));
      *(uint2*)(mix + (size_t)m * 1024 + n) = make_uint2(pack2(val[0] * silu(g0), val[1] * silu(g1)), pack2(val[2] * silu(g2), val[3] * silu(g3)));
    });
  }
}

__device__ void phase6(const Params& P, int l, int bid, int nb, float* sm, int skip_epi) {
  const bool last = (l == DEPTH - 1);
  const int nmt = last ? (NX + 191) / 192 : NT / 192;
  const int total = nmt * 8;
  for (int u = bid; u < total; u += nb) {
    int mt = u >> 3, nt = u & 7;
    const float* const modl = P.mod + (size_t)l * 9 * 3072;
    const float* const xs = (l == 0 ? P.x : P.out); const float* const cs = (l == 0 ? P.ctx : P.ctxw);
    float* const xo = P.out; float* const co = P.ctxw;
    gemm_tile<192>(P.hx, 1024, P.wtout, 1024, 1024, mt * 192, nt * 128, (u16*)sm, [=](int m, int n, f32x4 val) {
      if (skip_epi && val[0] != 12345.678f) return;
      if (last && m >= NX) return;
      int s = (m < NX) ? (m >> 11) : 8;
      float4 gt = *(const float4*)(modl + (size_t)s * 3072 + 2048 + n);
      const float* src; float* dst;
      if (m < NX) { src = xs + (size_t)m * 1024 + n; dst = xo + (size_t)m * 1024 + n; }
      else { src = cs + (size_t)(m - NX) * 1024 + n; dst = co + (size_t)(m - NX) * 1024 + n; }
      float4 xv = *(const float4*)src;
      float4 r = make_float4(xv.x + gt.x * val[0], xv.y + gt.y * val[1], xv.z + gt.z * val[2], xv.w + gt.w * val[3]);
      *(float4*)dst = r;
    });
  }
}

__device__ void phasef(const Params& P, int bid, int nb) {
  const int tid = get_tid(), lane = tid & 63, w = tid >> 6;
  for (int row0 = (bid * 4 + w) * 4; row0 < NX; row0 += nb * 16) {
    float* src = P.out + (size_t)row0 * 1024;
    float4 v[4][4];
#pragma unroll
    for (int rr = 0; rr < 4; ++rr)
#pragma unroll
      for (int p = 0; p < 4; ++p) v[rr][p] = *(const float4*)(src + rr * 1024 + (p * 64 + lane) * 4);
    float rstd[4];
#pragma unroll
    for (int rr = 0; rr < 4; ++rr) {
      float ss = 0.f;
#pragma unroll
      for (int p = 0; p < 4; ++p) ss += v[rr][p].x * v[rr][p].x + v[rr][p].y * v[rr][p].y + v[rr][p].z * v[rr][p].z + v[rr][p].w * v[rr][p].w;
      ss = wave_sum(ss);
      rstd[rr] = rsqrtf(ss * (1.f / 1024.f) + 1e-6f);
    }
#pragma unroll
    for (int p = 0; p < 4; ++p) {
      int c0 = (p * 64 + lane) * 4;
      float4 wv = *(const float4*)(P.norm_f + c0);
#pragma unroll
      for (int rr = 0; rr < 4; ++rr)
        *(float4*)(src + rr * 1024 + c0) = make_float4(v[rr][p].x * rstd[rr] * wv.x, v[rr][p].y * rstd[rr] * wv.y, v[rr][p].z * rstd[rr] * wv.z, v[rr][p].w * rstd[rr] * wv.w);
    }
  }
}

__global__ void __launch_bounds__(NTHREADS, 2) mega(Params P, int ph_lo, int ph_hi, int coop) {
  extern __shared__ __attribute__((aligned(16))) unsigned char lds[];
  float* sm = (float*)lds;
  cg::grid_group grid = cg::this_grid();
  const int bid = blockIdx.x, nb = gridDim.x;
  XcdBarrier xb = xcd_barrier_post(P.bar, (unsigned*)lds);
  int vbid = bid;
  for (int ph = ph_lo; ph < ph_hi; ++ph) {
    if (ph == 0) phase0(P, bid, nb, sm);
    else if (ph == 1 + 6 * DEPTH) phasef(P, bid, nb);
    else {
      int l = (ph - 1) / 6, sub = (ph - 1) % 6;
      if (ph == 1) vbid = xcd_vbid(xb);
      for (int rep = 0; rep < ((sub == REP_SUB) ? 2 : 1); ++rep) {
      if (rep) xcd_barrier(xb);
      switch (sub) {
        case 0: phase1(P, l, bid, nb, sm); break;
        case 1: phase2(P, vbid, nb, (u16*)sm, (PROBE_SKIP_EPI && rep) ? 1 : 0); break;
        case 2: phase3(P, l, vbid, nb, sm, rep ? PROBE_MASK : 7); break;
        case 3: phase4(P, l, bid, nb, sm, rep); break;
        case 4: phase5(P, l, bid, nb, sm); break;
        case 5: phase6(P, l, vbid, nb, sm, rep); break;
        default: break;
      }
      }
    }
    if (coop && ph + 1 < ph_hi) { if (coop == 2) grid.sync(); else xcd_barrier(xb); for (int e = 0; e < EXTRA_SYNCS; ++e) xcd_barrier(xb); }
  }
}

extern "C" void kernel_launch(void* const* d_in, const int* in_sizes, int n_in, void* d_out, int out_size, void* d_ws,
                              size_t ws_size, hipStream_t stream) {
  static int grid_blocks = 0;
  if (grid_blocks == 0) {
    int dev = 0, cus = 0, per_cu = 0;
    hipGetDevice(&dev);
    hipDeviceGetAttribute(&cus, hipDeviceAttributeMultiprocessorCount, dev);
    if (hipFuncSetAttribute((const void*)mega, hipFuncAttributeMaxDynamicSharedMemorySize, LDS_BYTES) != hipSuccess) {
      fprintf(stderr, "hipFuncSetAttribute failed\n");
    }
    hipOccupancyMaxActiveBlocksPerMultiprocessor(&per_cu, (const void*)mega, NTHREADS, LDS_BYTES);
    if (per_cu < 1) { fprintf(stderr, "occupancy query returned %d\n", per_cu); per_cu = 1; }
    if (per_cu > 2) per_cu = 2;
    grid_blocks = cus * per_cu;
  }
  Params P{};
  const float* const* in = (const float* const*)d_in;
  P.x = in[0]; P.c = in[1]; P.ctx = in[2]; P.c_ctx = in[3]; P.w_ada = in[4]; P.b_ada = in[5]; P.norm_w = in[6];
  P.w_in = in[7]; P.w_four = in[8]; P.rpb = in[9]; P.waf = in[10]; P.baf = in[11]; P.wab = in[12]; P.bab = in[13];
  P.gnw = in[14]; P.w_out = in[15]; P.norm_f = in[16];
  P.out = (float*)d_out;
  size_t off = 0;
  auto take = [&](size_t bytes) { void* p = (char*)d_ws + off; off += (bytes + 255) & ~(size_t)255; return p; };
  P.mod = (float*)take((size_t)4 * 9 * 3072 * 4);
  P.ropecs = (float*)take((size_t)2048 * 24 * 2 * 4);
  P.dft64 = (u16*)take((size_t)128 * 64 * 2);
  P.dftC = (u16*)take((size_t)256 * 512 * 2);
  P.dftL = (u16*)take((size_t)2048 * 4096 * 2);
  P.wtin = (u16*)take((size_t)DINP * 1024 * 2);
  P.wtout = (u16*)take((size_t)1024 * 1024 * 2);
  P.wtfour = (u16*)take((size_t)256 * 256 * 2);
  P.hx = (u16*)take((size_t)NT * 1024 * 2);
  P.proj = (u16*)take((size_t)NT * PSTR * 2);
  P.vtx = (u16*)take((size_t)8 * 256 * 4096 * 2);
  P.vtc = (u16*)take((size_t)8 * 256 * 512 * 2);
  P.natvx = (u16*)take((size_t)8 * 384 * 2048 * 2);
  P.natvc = (u16*)take((size_t)8 * 384 * 256 * 2);
  P.natkx = (u16*)take((size_t)8 * 384 * 2048 * 2);
  P.natkc = (u16*)take((size_t)8 * 384 * 256 * 2);
  P.ctxw = (float*)take((size_t)NC * 1024 * 4);
  P.kv = (u16*)take((size_t)NUNIT_G * 4608 * 2);
  P.dec = (float*)take((size_t)NUNIT_G * 48 * 4);
  P.gb = (float*)take((size_t)NUNIT_G * 3072 * 4);
  P.bar = (unsigned*)take((size_t)XCD_BAR_WORDS * 4);
  if (off > ws_size) { fprintf(stderr, "workspace too small: need %zu have %zu\n", off, ws_size); return; }
  if (hipMemsetAsync(P.bar, 0, (size_t)XCD_BAR_WORDS * 4, stream) != hipSuccess) { fprintf(stderr, "memset of barrier words failed\n"); return; }
  int ph_lo = 0, ph_hi = 2 + 6 * DEPTH, coop = 1;
  void* args[] = {&P, &ph_lo, &ph_hi, &coop};
  hipError_t e = hipLaunchCooperativeKernel((const void*)mega, dim3(grid_blocks), dim3(NTHREADS), args, LDS_BYTES, stream);
  if (e != hipSuccess) fprintf(stderr, "cooperative launch failed: %s (grid %d)\n", hipGetErrorString(e), grid_blocks);
}
```

```cpp
#include <hip/hip_runtime.h>
#include <hip/hip_bf16.h>
#include <hip/hip_cooperative_groups.h>
#include <cstdio>
namespace cg = cooperative_groups;

typedef unsigned short u16;
using bf16x8 = __attribute__((ext_vector_type(8))) short;
using f32x4 = __attribute__((ext_vector_type(4))) float;
using u32x4 = __attribute__((ext_vector_type(4))) unsigned;

#define NTHREADS 256
#define REP_SUB 100
#define EXTRA_SYNCS 0
#define PROBE_SKIP_EPI 0
#define PROBE_MASK 7
#define LDS_BYTES 81920

constexpr int DM = 1024, NB = 8, SEQ = 2048, DEPTH = 4, CTXL = 256;
constexpr int NX = NB * SEQ;
constexpr int NC = NB * CTXL;
constexpr int NT = NX + NC;
constexpr int DIN = 3232, DINP = 3328;
constexpr int N_NK = 896, N_NV = 1280, N_NG = 1664;
constexpr int PSTR = DIN - 768;
constexpr int C_FIN = 0, C_FG = 256, C_NQ = 512, C_NG = 896;
constexpr int C_GQ = 1280, C_GK = 1472, C_GV = 1664, C_GG = 2048, C_ZF = 2432, C_ZB = 2448;
constexpr int NCH = 36;
constexpr int NUNIT_G = NB * 4 * 2 * NCH;

struct Params {
  const float *x, *c, *ctx, *c_ctx, *w_ada, *b_ada, *norm_w, *w_in, *w_four, *rpb;
  const float *waf, *baf, *wab, *bab, *gnw, *w_out, *norm_f;
  float* out;
  float* mod;
  float* ropecs;
  u16* dft64;
  u16* dftC;
  u16* dftL;
  u16* wtin;
  u16* wtout;
  u16* wtfour;
  u16* hx;
  u16* proj;
  u16* vtx;
  u16* vtc;
  u16* natvx;
  u16* natvc;
  u16* natkx;
  u16* natkc;
  float* ctxw;
  u16* kv;
  float* dec;
  float* gb;
  unsigned* bar;
};

__device__ __forceinline__ int get_tid() { int t = threadIdx.x; asm volatile("" : "+v"(t)); return t; }
typedef __bf16 hbf16x2 __attribute__((ext_vector_type(2)));
typedef float hf32x2 __attribute__((ext_vector_type(2)));
__device__ __forceinline__ u16 f2bf(float f) { return __builtin_bit_cast(u16, (__bf16)f); }
__device__ __forceinline__ float bf2f(u16 h) { return __uint_as_float(((unsigned)h) << 16); }
__device__ __forceinline__ unsigned pack2(float a, float b) { hf32x2 f = {a, b}; return __builtin_bit_cast(unsigned, __builtin_convertvector(f, hbf16x2)); }
__device__ __forceinline__ float silu(float v) { return v / (1.f + __expf(-v)); }
__device__ __forceinline__ float wave_sum(float v) {
#pragma unroll
  for (int o = 32; o > 0; o >>= 1) v += __shfl_xor(v, o);
  return v;
}

#define XB_TMO      128
#define XB_XCNT(j)  (256  + 64 * (j))
#define XB_XSUB(j)  (1280 + 64 * (j))
#define XB_XGEN(j)  (2304 + 64 * (j))
#define XB_TOP      3328
#define XB_TOPGEN   3392
#define XCD_BAR_WORDS 3456
#define XB_SPIN_CAP (1u << 20)
#define LAS __attribute__((address_space(3)))
__device__ __forceinline__ unsigned xb_ld(unsigned* p)              { return __hip_atomic_load(p, __ATOMIC_RELAXED, __HIP_MEMORY_SCOPE_AGENT); }
__device__ __forceinline__ unsigned xb_add(unsigned* p, unsigned v) { return __hip_atomic_fetch_add(p, v, __ATOMIC_RELAXED, __HIP_MEMORY_SCOPE_AGENT); }
__device__ __forceinline__ unsigned xb_xcc_id() { return (unsigned)__builtin_amdgcn_s_getreg((3 << 11) | 20) & 0xFu; }
#define XB_SPIN(cond, bar) do { unsigned _sp = 0; while (cond) { __builtin_amdgcn_s_sleep(1); \
    if ((++_sp & 255u) == 0u) { if (xb_ld(&(bar)[XB_TMO])) break; if (_sp > XB_SPIN_CAP) { atomicAdd(&(bar)[XB_TMO], 1u); break; } } } } while (0)
struct XcdBarrier { unsigned* bar; unsigned x; unsigned nloc, nx, rank; };
__device__ __forceinline__ XcdBarrier xcd_barrier_post(unsigned* bar, unsigned* lds_word) {
  XcdBarrier b; b.bar = bar; b.x = xb_xcc_id(); b.nloc = 0u; b.nx = 0u;
  if (threadIdx.x == 0) *lds_word = xb_add(&bar[XB_XCNT(b.x)], 1u);
  __syncthreads();
  b.rank = *(volatile unsigned*)lds_word;
  __syncthreads();
  return b;
}
__device__ __forceinline__ void xcd_barrier_complete(unsigned* bar, unsigned x, unsigned& nloc, unsigned& nx) {
  const unsigned G = gridDim.x * gridDim.y * gridDim.z;
  unsigned sum, cnt, mine, sp = 0u;
  for (;;) {
    sum = 0u; cnt = 0u; mine = 0u;
#pragma unroll
    for (unsigned j = 0; j < 16; ++j) { const unsigned c = xb_ld(&bar[XB_XCNT(j)]); sum += c; cnt += (c > 0u) ? 1u : 0u; mine = (j == x) ? c : mine; }
    if (sum == G) break;
    __builtin_amdgcn_s_sleep(1);
    if ((++sp & 255u) == 0u) { if (xb_ld(&bar[XB_TMO])) break; if (sp > XB_SPIN_CAP) { atomicAdd(&bar[XB_TMO], 1u); break; } }
  }
  nloc = mine > 0u ? mine : 1u; nx = cnt > 0u ? cnt : 1u;
}
__device__ __forceinline__ void xcd_barrier(XcdBarrier& b) {
  asm volatile("s_waitcnt vmcnt(0)" ::: "memory");
  __syncthreads();
  if (threadIdx.x == 0) {
    unsigned* bar = b.bar;
    __builtin_amdgcn_s_waitcnt(0);
    unsigned nloc = b.nloc, nx = b.nx;
    if (nloc == 0u) { xcd_barrier_complete(bar, b.x, nloc, nx); b.nloc = nloc; b.nx = nx; }
    const unsigned old = xb_add(&bar[XB_XSUB(b.x)], 1u);
    const unsigned gen = old / nloc;
    if (old + 1u == (gen + 1u) * nloc) {
      __builtin_amdgcn_fence(__ATOMIC_RELEASE, "agent");
      asm volatile("s_waitcnt vmcnt(0)" ::: "memory");
      const unsigned og = xb_add(&bar[XB_TOP], 1u);
      const unsigned tg = og / nx;
      if (og + 1u == (tg + 1u) * nx) xb_add(&bar[XB_TOPGEN], 1u);
      else XB_SPIN(xb_ld(&bar[XB_TOPGEN]) == tg, bar);
      __builtin_amdgcn_fence(__ATOMIC_ACQUIRE, "agent");
      xb_add(&bar[XB_XGEN(b.x)], 1u);
      asm volatile("s_waitcnt vmcnt(0)" ::: "memory");
    } else {
      XB_SPIN(xb_ld(&bar[XB_XGEN(b.x)]) == gen, bar);
      __builtin_amdgcn_fence(__ATOMIC_ACQUIRE, "agent");
      asm volatile("s_waitcnt vmcnt(0)" ::: "memory");
    }
  }
  __syncthreads();
}

__device__ __forceinline__ int xcd_vbid(const XcdBarrier& b) {
  unsigned pre = 0;
#pragma unroll
  for (unsigned j = 0; j < 16; ++j) { const unsigned c = xb_ld(&b.bar[XB_XCNT(j)]); pre += (j < b.x) ? c : 0u; }
  return (int)(pre + b.rank);
}

template <int BM, int WIDE, class Epi>
__device__ __forceinline__ void gemm_tile(const u16* __restrict__ A, int lda, const u16* __restrict__ Bt, int ldb,
                                          int K, int m0, int n0, u16* smem, Epi epi) {
  constexpr int MI = BM / 32;
  constexpr int BUF = (BM + 128) * 64;
  const int tid = get_tid(), lane = tid & 63, w = tid >> 6;
  const int wm = w >> 1, wn = w & 1;
  f32x4 acc[MI][4];
#pragma unroll
  for (int i = 0; i < MI; ++i)
#pragma unroll
    for (int j = 0; j < 4; ++j) acc[i][j] = f32x4{0.f, 0.f, 0.f, 0.f};
  const int nk = K >> 6;
  const int srow = lane >> 3;
  const int schunk = (lane & 7) ^ (((w * 8 + srow) >> 1) & 7);
  const u16* ga = A + (size_t)(m0 + w * 8 + srow) * lda + schunk * 8;
  const u16* gb = Bt + (size_t)(n0 + w * 8 + srow) * ldb + schunk * 8;
  const size_t sa32 = (size_t)32 * lda, sb32 = (size_t)32 * ldb;
  const int woff = (w * 8) * 64 + lane * 8;
  const int rsw = ((lane & 15) >> 1) & 7;
  const int c0 = (((lane >> 4)) ^ rsw) * 8, c1 = ((4 + (lane >> 4)) ^ rsw) * 8;
  const int roffA = (wm * (BM / 2) + (lane & 15)) * 64;
  const int brow = WIDE ? (((((lane & 15) >> 2) & 1) * 2 + ((lane & 15) >> 3)) * 4 + (lane & 3)) : (lane & 15);
  const int rswB = (brow >> 1) & 7;
  const int c0B = (((lane >> 4)) ^ rswB) * 8, c1B = ((4 + (lane >> 4)) ^ rswB) * 8;
  const int roffB = BM * 64 + (wn * 64 + brow) * 64;
#define GLDS(gp, lp) __builtin_amdgcn_global_load_lds((const unsigned*)(gp), (unsigned*)(lp), 16, 0, 0)
#define G_ISSUE(buf, koff) { u16* _w = (buf) + woff; \
    _Pragma("unroll") for (int p = 0; p < MI; ++p) GLDS(ga + (koff) + p * sa32, _w + p * 32 * 64); \
    _w += BM * 64; \
    _Pragma("unroll") for (int p = 0; p < 4; ++p) GLDS(gb + (koff) + p * sb32, _w + p * 32 * 64); }
#define RAW_BARRIER() do { asm volatile("s_waitcnt lgkmcnt(0)" ::: "memory"); __builtin_amdgcn_s_barrier(); asm volatile("" ::: "memory"); } while (0)
  __syncthreads();
  G_ISSUE(smem, 0);
  if (nk > 1) G_ISSUE(smem + BUF, 64);
  for (int kt = 0; kt < nk; ++kt) {
    u16* cur = smem + (kt & 1) * BUF;
    if (kt + 1 < nk) {
      if (MI == 4) asm volatile("s_waitcnt vmcnt(8)" ::: "memory"); else asm volatile("s_waitcnt vmcnt(10)" ::: "memory");
    } else asm volatile("s_waitcnt vmcnt(0)" ::: "memory");
    RAW_BARRIER();
    __builtin_amdgcn_sched_barrier(0);
    bf16x8 af[2][MI], bfr[2][4];
#pragma unroll
    for (int i = 0; i < MI; ++i) af[0][i] = *(const bf16x8*)(cur + roffA + i * 16 * 64 + c0);
#pragma unroll
    for (int i = 0; i < 4; ++i) bfr[0][i] = *(const bf16x8*)(cur + roffB + i * 16 * 64 + c0B);
#pragma unroll
    for (int i = 0; i < MI; ++i) af[1][i] = *(const bf16x8*)(cur + roffA + i * 16 * 64 + c1);
#pragma unroll
    for (int i = 0; i < 4; ++i) bfr[1][i] = *(const bf16x8*)(cur + roffB + i * 16 * 64 + c1B);
    __builtin_amdgcn_sched_barrier(0);
    RAW_BARRIER();
    __builtin_amdgcn_sched_barrier(0);
    if (kt + 2 < nk) G_ISSUE(cur, (size_t)(kt + 2) * 64);
    __builtin_amdgcn_sched_barrier(0);
#pragma unroll
    for (int ks = 0; ks < 2; ++ks)
#pragma unroll
      for (int i = 0; i < MI; ++i)
#pragma unroll
        for (int j = 0; j < 4; ++j)
          acc[i][j] = __builtin_amdgcn_mfma_f32_16x16x32_bf16(bfr[ks][j], af[ks][i], acc[i][j], 0, 0, 0);
  }
#undef RAW_BARRIER
#undef GLDS
#undef G_ISSUE
  __syncthreads();
  if constexpr (WIDE) {
    const int g = lane >> 4;
#pragma unroll
    for (int i = 0; i < MI; ++i)
#pragma unroll
      for (int jp = 0; jp < 2; ++jp) {
        unsigned ax = pack2(acc[i][2 * jp][0], acc[i][2 * jp][1]), ay = pack2(acc[i][2 * jp][2], acc[i][2 * jp][3]);
        unsigned bx = pack2(acc[i][2 * jp + 1][0], acc[i][2 * jp + 1][1]), by = pack2(acc[i][2 * jp + 1][2], acc[i][2 * jp + 1][3]);
        auto rx = __builtin_amdgcn_permlane32_swap(ax, bx, false, false);
        auto ry = __builtin_amdgcn_permlane32_swap(ay, by, false, false);
        const int m = m0 + wm * (BM / 2) + i * 16 + (lane & 15);
        const int n8 = n0 + wn * 64 + (2 * jp + (g >> 1)) * 16 + (g & 1) * 8;
        epi(m, n8, make_uint4(rx[0], ry[0], rx[1], ry[1]));
      }
  } else {
#pragma unroll
    for (int i = 0; i < MI; ++i)
#pragma unroll
      for (int j = 0; j < 4; ++j) {
        int m = m0 + wm * (BM / 2) + i * 16 + (lane & 15);
        int n = n0 + wn * 64 + j * 16 + (lane >> 4) * 4;
        epi(m, n, acc[i][j]);
      }
  }
}

__device__ void tconv_unit(const float* __restrict__ src, int K, int N, u16* __restrict__ dst, int Npad, int unit, float* tile) {
  const int tid = get_tid();
  const int ntn = Npad >> 6;
  const int nt = unit % ntn, kt = unit / ntn;
  const int k0 = kt * 64, n0 = nt * 64;
  __syncthreads();
#pragma unroll
  for (int p = 0; p < 4; ++p) {
    int i = (tid >> 4) + 16 * p, j = (tid & 15) * 4;
    int n = n0 + j;
    float4 v = make_float4(0.f, 0.f, 0.f, 0.f);
    if (n < N) v = *(const float4*)(src + (size_t)(k0 + i) * N + n);
    tile[i * 65 + j + 0] = v.x; tile[i * 65 + j + 1] = v.y; tile[i * 65 + j + 2] = v.z; tile[i * 65 + j + 3] = v.w;
  }
  __syncthreads();
  {
    int nl = tid >> 2, ks = (tid & 3) * 16;
    unsigned pk[8];
#pragma unroll
    for (int q = 0; q < 8; ++q) pk[q] = pack2(tile[(ks + 2 * q) * 65 + nl], tile[(ks + 2 * q + 1) * 65 + nl]);
    u16* d = dst + (size_t)(n0 + nl) * K + k0 + ks;
    *(uint4*)d = make_uint4(pk[0], pk[1], pk[2], pk[3]);
    *(uint4*)(d + 8) = make_uint4(pk[4], pk[5], pk[6], pk[7]);
  }
}

__device__ void phase0(const Params& P, int bid, int nb, float* sm) {
  const int tid = get_tid();
  float* sv = sm;
  float* red = sm + 9216;
  if (bid < 192) {
    for (int i = tid; i < 9 * 1024; i += NTHREADS) {
      int s = i >> 10, k = i & 1023;
      float v = (s < 8) ? P.c[s * 1024 + k] : P.c_ctx[k];
      sv[i] = silu(v);
    }
    __syncthreads();
    for (int unit = bid; unit < 192; unit += nb) {
      int col0 = unit * 64;
      int l = col0 / 3072, n0 = col0 % 3072;
      int kg = tid >> 6, col = tid & 63;
      float acc[9];
#pragma unroll
      for (int s = 0; s < 9; ++s) acc[s] = 0.f;
      const float* wp = P.w_ada + (size_t)l * 1024 * 3072 + n0 + col;
      for (int k0 = kg * 256; k0 < kg * 256 + 256; k0 += 32) {
        float wv[32];
#pragma unroll
        for (int q = 0; q < 32; ++q) wv[q] = wp[(size_t)(k0 + q) * 3072];
#pragma unroll
        for (int q = 0; q < 32; ++q)
#pragma unroll
          for (int s = 0; s < 9; ++s) acc[s] += sv[s * 1024 + k0 + q] * wv[q];
      }
#pragma unroll
      for (int s = 0; s < 9; ++s) red[(kg * 9 + s) * 64 + col] = acc[s];
      __syncthreads();
      for (int o = tid; o < 576; o += NTHREADS) {
        int s = o >> 6, cc = o & 63;
        float v = red[(0 * 9 + s) * 64 + cc] + red[(1 * 9 + s) * 64 + cc] + red[(2 * 9 + s) * 64 + cc] + red[(3 * 9 + s) * 64 + cc];
        P.mod[((size_t)l * 9 + s) * 3072 + n0 + cc] = v + P.b_ada[l * 3072 + n0 + cc];
      }
      __syncthreads();
    }
  }
  const int gtid = bid * NTHREADS + tid, gsz = nb * NTHREADS;
  const float sL = 0.022097086912079608f;
  for (int i8 = gtid; i8 < 2048 * 512; i8 += gsz) {
    int k = i8 >> 9, t0 = (i8 & 511) * 8;
    unsigned pk[4];
#pragma unroll
    for (int j = 0; j < 4; ++j) {
      float v[2];
#pragma unroll
      for (int e = 0; e < 2; ++e) {
        int tc = t0 + 2 * j + e;
        int t = tc & 2047;
        int m = (k * t) & 2047;
        float a = (float)m * (1.f / 1024.f);
        v[e] = (tc < 2048) ? cospif(a) * sL : -sinpif(a) * sL;
      }
      pk[j] = pack2(v[0], v[1]);
    }
    *(uint4*)(P.dftL + (size_t)k * 4096 + t0) = make_uint4(pk[0], pk[1], pk[2], pk[3]);
  }
  for (int i = gtid; i < 256 * 512; i += gsz) {
    int k = i >> 9, tc = i & 511, t = tc & 255;
    int m = (k * t) & 255;
    float a = (float)m * (1.f / 128.f);
    float v = (tc < 256) ? cospif(a) * 0.0625f : -sinpif(a) * 0.0625f;
    P.dftC[i] = f2bf(v);
  }
  for (int i = gtid; i < 128 * 64; i += gsz) {
    int r = i >> 6, cc = i & 63, j = r & 63;
    int m = (j * cc) & 63;
    float a = (float)m * (1.f / 32.f);
    float v = (r < 64) ? cospif(a) * 0.125f : sinpif(a) * 0.125f;
    P.dft64[i] = f2bf(v);
  }
  for (int i = gtid; i < 2048 * 24; i += gsz) {
    int t = i / 24, f = i % 24;
    int fi = f % 12;
    float pos = (f < 12) ? (float)(t >> 6) : (float)(t & 63);
    float inv = powf(10000.f, -(float)fi / 12.f);
    float ang = pos * inv;
    P.ropecs[2 * i] = cosf(ang);
    P.ropecs[2 * i + 1] = sinf(ang);
  }
}

__device__ void phase1(const Params& P, int l, int bid, int nb, float* sm) {
  const int tid = get_tid(), lane = tid & 63, w = tid >> 6;
  const int u_in = 16 * (DINP / 64), u_out = 16 * 16, u_four = 4 * 4;
  for (int u = bid; u < u_in + u_out + u_four; u += nb) {
    if (u < u_in) tconv_unit(P.w_in + (size_t)l * 1024 * DIN, 1024, DIN, P.wtin, DINP, u, sm);
    else if (u < u_in + u_out) tconv_unit(P.w_out + (size_t)l * 1024 * 1024, 1024, 1024, P.wtout, 1024, u - u_in, sm);
    else tconv_unit(P.w_four + (size_t)l * 256 * 256, 256, 256, P.wtfour, 256, u - u_in - u_out, sm);
  }
  const float* nw = P.norm_w + l * 1024;
  for (int row0 = (bid * 4 + w) * 4; row0 < NT; row0 += nb * 16) {
    const float* src;
    int s;
    if (row0 < NX) { src = (l == 0 ? P.x : P.out) + (size_t)row0 * 1024; s = row0 >> 11; }
    else { src = (l == 0 ? P.ctx : P.ctxw) + (size_t)(row0 - NX) * 1024; s = 8; }
    const float* md = P.mod + ((size_t)l * 9 + s) * 3072;
    float4 v[4][4];
#pragma unroll
    for (int rr = 0; rr < 4; ++rr)
#pragma unroll
      for (int p = 0; p < 4; ++p) v[rr][p] = *(const float4*)(src + rr * 1024 + (p * 64 + lane) * 4);
    float rstd[4];
#pragma unroll
    for (int rr = 0; rr < 4; ++rr) {
      float ss = 0.f;
#pragma unroll
      for (int p = 0; p < 4; ++p) ss += v[rr][p].x * v[rr][p].x + v[rr][p].y * v[rr][p].y + v[rr][p].z * v[rr][p].z + v[rr][p].w * v[rr][p].w;
      ss = wave_sum(ss);
      rstd[rr] = rsqrtf(ss * (1.f / 1024.f) + 1e-6f);
    }
#pragma unroll
    for (int p = 0; p < 4; ++p) {
      int c0 = (p * 64 + lane) * 4;
      float4 wv = *(const float4*)(nw + c0);
      float4 sh = *(const float4*)(md + c0);
      float4 sc = *(const float4*)(md + 1024 + c0);
      const float a0 = wv.x * (1.f + sc.x), a1 = wv.y * (1.f + sc.y), a2 = wv.z * (1.f + sc.z), a3 = wv.w * (1.f + sc.w);
#pragma unroll
      for (int rr = 0; rr < 4; ++rr) {
        float o0 = v[rr][p].x * rstd[rr] * a0 + sh.x;
        float o1 = v[rr][p].y * rstd[rr] * a1 + sh.y;
        float o2 = v[rr][p].z * rstd[rr] * a2 + sh.z;
        float o3 = v[rr][p].w * rstd[rr] * a3 + sh.w;
        *(uint2*)(P.hx + (size_t)(row0 + rr) * 1024 + c0) = make_uint2(pack2(o0, o1), pack2(o2, o3));
      }
    }
  }
}

__device__ void phase2(const Params& P, int bid, int nb, u16* sm, int skip_epi) {
  const int ntn = DINP / 128;
  constexpr int NMT = NT / 192;
  const int total = NMT * ntn;
  for (int L = bid; L < total; L += nb) {
    int mt, nt;
    if (L < NMT * 24) { int band = L / (NMT * 8), q = L % (NMT * 8); mt = q >> 3; nt = band * 8 + (q & 7); }
    else { int q = L - NMT * 24; mt = q >> 1; nt = 24 + (q & 1); }
    u16* const proj = P.proj; u16* const natvx = P.natvx; u16* const natvc = P.natvc; u16* const natkx = P.natkx; u16* const natkc = P.natkc;
    gemm_tile<192, 1>(P.hx, 1024, P.wtin, 1024, 1024, mt * 192, nt * 128, sm, [=](int m, int n, uint4 pk) {
      if (skip_epi && pk.x != 0x12345678u) return;
      if (n < DIN) {
        if (n >= N_NK && n < N_NG) {
          if (n < N_NV) {
            int hd = n - N_NK, h = hd >> 6, d = hd & 63;
            if (m < NX) { int b = m >> 11, t = m & 2047; *(uint4*)(natkx + (((size_t)(b * 6 + h)) * 2048 + t) * 64 + d) = pk; }
            else { int mc = m - NX, b = mc >> 8, t = mc & 255; *(uint4*)(natkc + (((size_t)(b * 6 + h)) * 256 + t) * 64 + d) = pk; }
          } else {
            int hd = n - N_NV, h = hd >> 6, d = hd & 63;
            u16* dst;
            if (m < NX) { int b = m >> 11, t = m & 2047; dst = natvx + ((((size_t)(b * 6 + h)) * 256 + (t >> 3)) * 64 + d) * 8 + (t & 7); }
            else { int mc = m - NX, b = mc >> 8, t = mc & 255; dst = natvc + ((((size_t)(b * 6 + h)) * 32 + (t >> 3)) * 64 + d) * 8 + (t & 7); }
            dst[0] = (u16)(pk.x & 0xffffu); dst[8] = (u16)(pk.x >> 16); dst[16] = (u16)(pk.y & 0xffffu); dst[24] = (u16)(pk.y >> 16);
            dst[32] = (u16)(pk.z & 0xffffu); dst[40] = (u16)(pk.z >> 16); dst[48] = (u16)(pk.w & 0xffffu); dst[56] = (u16)(pk.w >> 16);
          }
        } else {
          *(uint4*)(proj + (size_t)m * PSTR + (n < N_NK ? n : n - 768)) = pk;
        }
      }
    });
  }
}

struct NaFrag { bf16x8 ka0, ka1, kb0, kb1, v0, v1, v2, v3; };
template <bool LOCAL>
__device__ __forceinline__ void na_load(int kp, const u16* __restrict__ kbase, const u16* __restrict__ vbase, NaFrag& f) {
  const u16* kp0 = kbase + (size_t)(kp * (LOCAL ? 64 : 32)) * 64;
  f.ka0 = *(const bf16x8*)(kp0);
  f.ka1 = *(const bf16x8*)(kp0 + 32);
  f.kb0 = *(const bf16x8*)(kp0 + 4 * 64);
  f.kb1 = *(const bf16x8*)(kp0 + 4 * 64 + 32);
  const u16* vp = vbase + (size_t)(kp * (LOCAL ? 8 : 4)) * 512;
  f.v0 = *(const bf16x8*)(vp);
  f.v1 = *(const bf16x8*)(vp + 128);
  f.v2 = *(const bf16x8*)(vp + 256);
  f.v3 = *(const bf16x8*)(vp + 384);
}
template <bool LOCAL>
__device__ __forceinline__ void na_step(const NaFrag& f, const bf16x8 qf0, const bf16x8 qf1, const float* bp, const int (&bidx)[8],
                                        float& mrun, float& lrun, f32x4 (&o)[4]) {
  constexpr float SC = 0.125f * 1.4426950408889634f;
  {
    const bf16x8 ka0 = f.ka0, ka1 = f.ka1, kb0 = f.kb0, kb1 = f.kb1;
    f32x4 s0 = f32x4{0.f, 0.f, 0.f, 0.f}, s1 = f32x4{0.f, 0.f, 0.f, 0.f};
    s0 = __builtin_amdgcn_mfma_f32_16x16x32_bf16(ka0, qf0, s0, 0, 0, 0);
    s1 = __builtin_amdgcn_mfma_f32_16x16x32_bf16(kb0, qf0, s1, 0, 0, 0);
    s0 = __builtin_amdgcn_mfma_f32_16x16x32_bf16(ka1, qf1, s0, 0, 0, 0);
    s1 = __builtin_amdgcn_mfma_f32_16x16x32_bf16(kb1, qf1, s1, 0, 0, 0);
    float mx;
    if (LOCAL) {
#pragma unroll
      for (int e = 0; e < 4; ++e) { s0[e] = fmaf(s0[e], SC, bp[bidx[e]]); s1[e] = fmaf(s1[e], SC, bp[bidx[4 + e]]); }
    } else {
#pragma unroll
      for (int e = 0; e < 4; ++e) { s0[e] *= SC; s1[e] *= SC; }
    }
    mx = fmaxf(fmaxf(fmaxf(s0[0], s0[1]), fmaxf(s0[2], s0[3])), fmaxf(fmaxf(s1[0], s1[1]), fmaxf(s1[2], s1[3])));
    mx = fmaxf(mx, __shfl_xor(mx, 16));
    mx = fmaxf(mx, __shfl_xor(mx, 32));
    const float mnew = fmaxf(mrun, mx);
    const float alpha = __builtin_amdgcn_exp2f(mrun - mnew);
    float sum = 0.f;
#pragma unroll
    for (int e = 0; e < 4; ++e) {
      float p0 = __builtin_amdgcn_exp2f(s0[e] - mnew), p1 = __builtin_amdgcn_exp2f(s1[e] - mnew);
      s0[e] = p0; s1[e] = p1;
      sum += p0 + p1;
    }
    sum += __shfl_xor(sum, 16);
    sum += __shfl_xor(sum, 32);
    lrun = lrun * alpha + sum;
    mrun = mnew;
    u32x4 pu;
    pu[0] = pack2(s0[0], s0[1]);
    pu[1] = pack2(s0[2], s0[3]);
    pu[2] = pack2(s1[0], s1[1]);
    pu[3] = pack2(s1[2], s1[3]);
    const bf16x8 pfv = __builtin_bit_cast(bf16x8, pu);
#pragma unroll
    for (int dt = 0; dt < 4; ++dt) o[dt] = o[dt] * alpha;
    o[0] = __builtin_amdgcn_mfma_f32_16x16x32_bf16(f.v0, pfv, o[0], 0, 0, 0);
    o[1] = __builtin_amdgcn_mfma_f32_16x16x32_bf16(f.v1, pfv, o[1], 0, 0, 0);
    o[2] = __builtin_amdgcn_mfma_f32_16x16x32_bf16(f.v2, pfv, o[2], 0, 0, 0);
    o[3] = __builtin_amdgcn_mfma_f32_16x16x32_bf16(f.v3, pfv, o[3], 0, 0, 0);
  }
}

__device__ __forceinline__ int na_kswz(int key) { return (((key >> 3) & 3) << 1) | ((key >> 1) & 1); }
template <bool LAT>
__device__ __forceinline__ void na_unit(const Params& P, int l, int unit, float* sm) {
  const int tid = get_tid(), lane = tid & 63, w = __builtin_amdgcn_readfirstlane(tid >> 6);
  const int qi = lane & 15, g = lane >> 4;
  int b, h, r = 0, c0 = 0, m;
  float* srpb = sm;
  u16* ring = (u16*)(sm + 512);
  constexpr int KL = 0, VL = 4096, KC = LAT ? 8192 : 0, VC = LAT ? 10240 : 2048, SLOT = LAT ? 12288 : 4096;
  constexpr int NI = LAT ? 6 : 2;
  __syncthreads();
  if (LAT) {
    r = unit & 31; h = (unit >> 5) % 6; b = unit / 192;
    c0 = 16 * w;
    m = b * 2048 + r * 64 + c0 + qi;
    for (int i = tid; i < 15 * 32; i += NTHREADS) { int rw = i >> 5, cc = i & 31; srpb[i] = (cc < 31) ? P.rpb[((size_t)l * 6 + h) * 465 + rw * 31 + cc] * 1.4426950408889634f : -1e30f; }
  } else {
    int qt = unit & 3; h = (unit >> 2) % 6; b = unit / 24;
    m = NX + b * 256 + (qt * 4 + w) * 16 + qi;
  }
  const u16* proj = P.proj;
  const bf16x8 qf0 = *(const bf16x8*)(proj + (size_t)m * PSTR + C_NQ + h * 64 + g * 8);
  const bf16x8 qf1 = *(const bf16x8*)(proj + (size_t)m * PSTR + C_NQ + h * 64 + 32 + g * 8);
  const int rs = LAT ? min(max(r - 4, 0), 24) : 0;
  const int ws = LAT ? min(max(c0 - 8, 0), 32) : 0;
  const int qc = c0 + qi;
  const int cs = min(max(qc - 8, 0), 48);
  const int dkey = lane >> 3, dslot = lane & 7;
  const size_t bh = (size_t)(b * 6 + h);
  const u16* gKL0 = P.natkx + (bh * 2048 + rs * 64 + w * 8 + dkey) * 64 + ((dslot ^ na_kswz(w * 8 + dkey)) * 8);
  const u16* gKL1 = P.natkx + (bh * 2048 + rs * 64 + 32 + w * 8 + dkey) * 64 + ((dslot ^ na_kswz(32 + w * 8 + dkey)) * 8);
  const u16* gVL0 = P.natvx + (bh * 256 + rs * 8) * 512 + w * 512 + lane * 8;
  const u16* gVL1 = gVL0 + 4 * 512;
  const u16* gKC = P.natkc + (bh * 256 + w * 8 + dkey) * 64 + ((dslot ^ na_kswz(w * 8 + dkey)) * 8);
  const u16* gVC = P.natvc + (bh * 32) * 512 + w * 512 + lane * 8;
  const int lseg = w * 512 + lane * 8;
#define GLDS(gp, lp) __builtin_amdgcn_global_load_lds((const unsigned*)(gp), (unsigned*)(lp), 16, 0, 0)
  const u16 *pKL0 = gKL0, *pKL1 = gKL1, *pVL0 = gVL0, *pVL1 = gVL1, *pKC = gKC, *pVC = gVC;
#define NA_ISSUE(slot) { u16* _s = ring + (slot) * SLOT; \
    if (LAT) { GLDS(pKL0, _s + KL + lseg); GLDS(pKL1, _s + KL + 2048 + lseg); GLDS(pVL0, _s + VL + lseg); GLDS(pVL1, _s + VL + 2048 + lseg); \
               pKL0 += 64 * 64; pKL1 += 64 * 64; pVL0 += 8 * 512; pVL1 += 8 * 512; } \
    GLDS(pKC, _s + KC + lseg); GLDS(pVC, _s + VC + lseg); pKC += 32 * 64; pVC += 4 * 512; }
#define RAW_BARRIER() do { asm volatile("s_waitcnt lgkmcnt(0)" ::: "memory"); __builtin_amdgcn_s_barrier(); asm volatile("" ::: "memory"); } while (0)
  const int prow = (qi >> 2) * 8 + (qi & 3);
  const int fL = na_kswz(ws + prow), fC = na_kswz(prow);
  const int rKL = KL + (ws + prow) * 64, rKC = KC + prow * 64;
  const int cL0 = ((g) ^ fL) * 8, cL1 = ((4 + g) ^ fL) * 8, cC0 = ((g) ^ fC) * 8, cC1 = ((4 + g) ^ fC) * 8;
  const int rVL = VL + (((ws >> 3) + g) * 64 + qi) * 8, rVC = VC + (g * 64 + qi) * 8;
  int bidx[8];
#pragma unroll
  for (int j = 0; j < 8; ++j) {
    int kc = ws + g * 8 + j;
    bool ok = (kc >= cs) && (kc < cs + 16);
    bidx[j] = ok ? min(max(kc - qc + 15, 0), 30) : 31;
  }
  float mL = -1e30f, lL = 0.f, mC = -1e30f, lC = 0.f;
  f32x4 oL[4], o[4];
#pragma unroll
  for (int dt = 0; dt < 4; ++dt) { oL[dt] = f32x4{0.f, 0.f, 0.f, 0.f}; o[dt] = f32x4{0.f, 0.f, 0.f, 0.f}; }
  asm volatile("s_waitcnt vmcnt(0)" ::: "memory");
  NA_ISSUE(0); NA_ISSUE(1); NA_ISSUE(2);
  int slot = 0;
#pragma unroll 1
  for (int kp = 0; kp < 8; ++kp) {
    if (kp <= 5) { if (LAT) asm volatile("s_waitcnt vmcnt(12)" ::: "memory"); else asm volatile("s_waitcnt vmcnt(4)" ::: "memory"); }
    else if (kp == 6) { if (LAT) asm volatile("s_waitcnt vmcnt(6)" ::: "memory"); else asm volatile("s_waitcnt vmcnt(2)" ::: "memory"); }
    else asm volatile("s_waitcnt vmcnt(0)" ::: "memory");
    RAW_BARRIER();
    __builtin_amdgcn_sched_barrier(0);
    const u16* sl = ring + slot * SLOT;
    NaFrag FL, FC;
    if (LAT) {
      FL.ka0 = *(const bf16x8*)(sl + rKL + cL0); FL.ka1 = *(const bf16x8*)(sl + rKL + cL1);
      FL.kb0 = *(const bf16x8*)(sl + rKL + 4 * 64 + cL0); FL.kb1 = *(const bf16x8*)(sl + rKL + 4 * 64 + cL1);
      FL.v0 = *(const bf16x8*)(sl + rVL); FL.v1 = *(const bf16x8*)(sl + rVL + 128); FL.v2 = *(const bf16x8*)(sl + rVL + 256); FL.v3 = *(const bf16x8*)(sl + rVL + 384);
    }
    FC.ka0 = *(const bf16x8*)(sl + rKC + cC0); FC.ka1 = *(const bf16x8*)(sl + rKC + cC1);
    FC.kb0 = *(const bf16x8*)(sl + rKC + 4 * 64 + cC0); FC.kb1 = *(const bf16x8*)(sl + rKC + 4 * 64 + cC1);
    FC.v0 = *(const bf16x8*)(sl + rVC); FC.v1 = *(const bf16x8*)(sl + rVC + 128); FC.v2 = *(const bf16x8*)(sl + rVC + 256); FC.v3 = *(const bf16x8*)(sl + rVC + 384);
    __builtin_amdgcn_sched_barrier(0);
    RAW_BARRIER();
    __builtin_amdgcn_sched_barrier(0);
    if (kp + 3 < 8) NA_ISSUE(slot);
    slot = (slot == 2) ? 0 : slot + 1;
    __builtin_amdgcn_sched_barrier(0);
    if (LAT) na_step<true>(FL, qf0, qf1, srpb + (rs + kp - r + 7) * 32, bidx, mL, lL, oL);
    na_step<false>(FC, qf0, qf1, srpb, bidx, mC, lC, o);
  }
#undef GLDS
#undef NA_ISSUE
#undef RAW_BARRIER
  float lrun = lC;
  if (LAT) {
    const float mm = fmaxf(mL, mC);
    const float aL = __builtin_amdgcn_exp2f(mL - mm), aC = __builtin_amdgcn_exp2f(mC - mm);
    lrun = lL * aL + lC * aC;
#pragma unroll
    for (int dt = 0; dt < 4; ++dt) o[dt] = oL[dt] * aL + o[dt] * aC;
  }
  const float rinv = 1.f / lrun;
#pragma unroll
  for (int dt = 0; dt < 4; ++dt) {
    int d = h * 64 + dt * 16 + g * 4;
    uint2 gg = *(const uint2*)(proj + (size_t)m * PSTR + C_NG + d);
    float g0 = bf2f((u16)(gg.x & 0xffff)), g1 = bf2f((u16)(gg.x >> 16)), g2 = bf2f((u16)(gg.y & 0xffff)), g3 = bf2f((u16)(gg.y >> 16));
    float o0 = o[dt][0] * rinv * silu(g0), o1 = o[dt][1] * rinv * silu(g1), o2 = o[dt][2] * rinv * silu(g2), o3 = o[dt][3] * rinv * silu(g3);
    *(uint2*)(P.hx + (size_t)m * 1024 + 256 + d) = make_uint2(pack2(o0, o1), pack2(o2, o3));
  }
}

__device__ __forceinline__ int gla_tok_row(int b, int c, int tk) {
  return (c < 4) ? (NX + b * 256 + c * 64 + tk) : (b * 2048 + (c - 4) * 64 + tk);
}
__device__ __forceinline__ void unpack8(const uint4 v, float* f) {
  f[0] = __uint_as_float(v.x << 16); f[1] = __uint_as_float(v.x & 0xffff0000u);
  f[2] = __uint_as_float(v.y << 16); f[3] = __uint_as_float(v.y & 0xffff0000u);
  f[4] = __uint_as_float(v.z << 16); f[5] = __uint_as_float(v.z & 0xffff0000u);
  f[6] = __uint_as_float(v.w << 16); f[7] = __uint_as_float(v.w & 0xffff0000u);
}
__device__ __forceinline__ void load24(const u16* p, float* f) {
  uint4 a = *(const uint4*)(p), b = *(const uint4*)(p + 8), c = *(const uint4*)(p + 16);
  unpack8(a, f); unpack8(b, f + 8); unpack8(c, f + 16);
}
template <int MODE>
__device__ __forceinline__ void gla_prep(const Params& P, int l, int b, int h, int c, int dir, u16* s0, u16* s1, float* decp, float* gla_stage, float* bstore) {
  const int tid = get_tid(), lane = tid & 63, w = __builtin_amdgcn_readfirstlane(tid >> 6);
  const bool lat = c >= 4;
  const int row = gla_tok_row(b, c, lane);
  const u16* prow = P.proj + (size_t)row * PSTR;
  const int half = w >> 1, hi = w & 1;
  float cs[24];
  if (lat) {
    const float* cp = P.ropecs + ((size_t)(row & 2047) * 24 + half * 12) * 2;
#pragma unroll
    for (int q = 0; q < 6; ++q) {
      float4 v = *(const float4*)(cp + 4 * q);
      cs[4 * q] = v.x; cs[4 * q + 1] = v.y; cs[4 * q + 2] = v.z; cs[4 * q + 3] = v.w;
    }
  } else {
#pragma unroll
    for (int q = 0; q < 12; ++q) { cs[2 * q] = 1.f; cs[2 * q + 1] = 0.f; }
  }
  uint4 kraw0 = *(const uint4*)(prow + C_GK + h * 48 + half * 24), kraw1 = *(const uint4*)(prow + C_GK + h * 48 + half * 24 + 8), kraw2 = *(const uint4*)(prow + C_GK + h * 48 + half * 24 + 16);
  uint4 qraw0 = kraw0, qraw1 = kraw1, qraw2 = kraw2;
  if (MODE == 1) { qraw0 = *(const uint4*)(prow + C_GQ + h * 48 + half * 24); qraw1 = *(const uint4*)(prow + C_GQ + h * 48 + half * 24 + 8); qraw2 = *(const uint4*)(prow + C_GQ + h * 48 + half * 24 + 16); }
  float bb[12];
  float* const bmine = bstore + lane * 48 + 12 * w;
  if (MODE == 0) {
  const float* wag = (dir ? P.wab : P.waf) + (size_t)l * 16 * 192 + h * 48;
  const float* ba = (dir ? P.bab : P.baf) + (size_t)l * 192 + h * 48 + 12 * w;
  float* swa = gla_stage;
  float* sz = gla_stage + 768;
  __syncthreads();
  for (int i = tid; i < 768; i += NTHREADS) { int rr = i / 48, kk = i % 48; swa[i] = wag[rr * 192 + kk]; }
  {
    int tk = tid >> 2, q = tid & 3;
    uint2 zz = *(const uint2*)(P.proj + (size_t)gla_tok_row(b, c, tk) * PSTR + C_ZF + dir * 16 + q * 4);
    float* d = sz + tk * 17 + q * 4;
    d[0] = __uint_as_float(zz.x << 16); d[1] = __uint_as_float(zz.x & 0xffff0000u);
    d[2] = __uint_as_float(zz.y << 16); d[3] = __uint_as_float(zz.y & 0xffff0000u);
  }
  __syncthreads();
#pragma unroll
  for (int j = 0; j < 12; ++j) bb[j] = ba[j];
#pragma unroll 1
  for (int rr = 0; rr < 16; ++rr) {
    const float zv = sz[lane * 17 + rr];
    const float4 w0 = *(const float4*)(swa + rr * 48 + 12 * w);
    const float4 w1 = *(const float4*)(swa + rr * 48 + 12 * w + 4);
    const float4 w2 = *(const float4*)(swa + rr * 48 + 12 * w + 8);
    bb[0] += zv * w0.x; bb[1] += zv * w0.y; bb[2] += zv * w0.z; bb[3] += zv * w0.w;
    bb[4] += zv * w1.x; bb[5] += zv * w1.y; bb[6] += zv * w1.z; bb[7] += zv * w1.w;
    bb[8] += zv * w2.x; bb[9] += zv * w2.y; bb[10] += zv * w2.z; bb[11] += zv * w2.w;
  }
#pragma unroll
  for (int j = 0; j < 12; ++j) {
    float gsum = bb[j];
    float ls = fminf(gsum, 0.f) - __logf(1.f + __expf(-fabsf(gsum)));
    bb[j] = ls * (1.f / 16.f);
  }
#pragma unroll
  for (int off = 1; off < 64; off <<= 1) {
#pragma unroll
    for (int j = 0; j < 12; ++j) {
      float t = dir ? __shfl_down(bb[j], off) : __shfl_up(bb[j], off);
      bool ok = dir ? (lane + off < 64) : (lane >= off);
      bb[j] += ok ? t : 0.f;
    }
  }
  *(float4*)(bmine) = make_float4(bb[0], bb[1], bb[2], bb[3]);
  *(float4*)(bmine + 4) = make_float4(bb[4], bb[5], bb[6], bb[7]);
  *(float4*)(bmine + 8) = make_float4(bb[8], bb[9], bb[10], bb[11]);
  } else {
    const float4 b0 = *(const float4*)(bmine), b1 = *(const float4*)(bmine + 4), b2 = *(const float4*)(bmine + 8);
    bb[0] = b0.x; bb[1] = b0.y; bb[2] = b0.z; bb[3] = b0.w; bb[4] = b1.x; bb[5] = b1.y; bb[6] = b1.z; bb[7] = b1.w;
    bb[8] = b2.x; bb[9] = b2.y; bb[10] = b2.z; bb[11] = b2.w;
  }
  float kr[24];
  unpack8(kraw0, kr); unpack8(kraw1, kr + 8); unpack8(kraw2, kr + 16);
  if (MODE == 0) {
    unsigned pk[6];
    float bend[12];
#pragma unroll
    for (int j = 0; j < 12; ++j) bend[j] = __shfl(bb[j], dir ? 0 : 63);
#pragma unroll
    for (int j = 0; j < 12; ++j) {
      float c0 = cs[2 * j], s0v = cs[2 * j + 1];
      float rot = hi ? (kr[j] * s0v + kr[12 + j] * c0) : (kr[j] * c0 - kr[12 + j] * s0v);
      float val = rot * __expf(bend[j] - bb[j]);
      s0[(12 * w + j) * 72 + lane] = f2bf(val);
    }
    if (lane == 0) {
#pragma unroll
      for (int j = 0; j < 12; ++j) decp[12 * w + j] = __expf(bend[j]);
    }
    (void)pk;
  } else {
    float qr[24];
    unpack8(qraw0, qr); unpack8(qraw1, qr + 8); unpack8(qraw2, qr + 16);
    unsigned pq[6], pkk[6];
#pragma unroll
    for (int j2 = 0; j2 < 6; ++j2) {
      float vq[2], vk[2];
#pragma unroll
      for (int e = 0; e < 2; ++e) {
        int j = 2 * j2 + e;
        float c0 = cs[2 * j], s0v = cs[2 * j + 1];
        float rq = hi ? (qr[j] * s0v + qr[12 + j] * c0) : (qr[j] * c0 - qr[12 + j] * s0v);
        float rk = hi ? (kr[j] * s0v + kr[12 + j] * c0) : (kr[j] * c0 - kr[12 + j] * s0v);
        float eb = __expf(bb[j]);
        vq[e] = rq * 0.14433756729740643f * eb;
        vk[e] = rk / eb;
      }
      pq[j2] = pack2(vq[0], vq[1]);
      pkk[j2] = pack2(vk[0], vk[1]);
    }
    u16* dq = s0 + lane * 72 + 12 * w;
    u16* dk = s1 + lane * 72 + 12 * w;
    *(uint2*)(dq) = make_uint2(pq[0], pq[1]); *(uint2*)(dq + 4) = make_uint2(pq[2], pq[3]); *(uint2*)(dq + 8) = make_uint2(pq[4], pq[5]);
    *(uint2*)(dk) = make_uint2(pkk[0], pkk[1]); *(uint2*)(dk + 4) = make_uint2(pkk[2], pkk[3]); *(uint2*)(dk + 8) = make_uint2(pkk[4], pkk[5]);
  }
}
__device__ __forceinline__ void gla_load_vT(const Params& P, int b, int h, int c, u16* svT) {
  const int tid = get_tid(), lane = tid & 63, w = __builtin_amdgcn_readfirstlane(tid >> 6);
  const u16* p = P.proj + (size_t)gla_tok_row(b, c, lane) * PSTR + C_GV + h * 96 + 24 * w;
  uint4 a = *(const uint4*)(p), bq = *(const uint4*)(p + 8), cq = *(const uint4*)(p + 16);
  unsigned wv[12] = {a.x, a.y, a.z, a.w, bq.x, bq.y, bq.z, bq.w, cq.x, cq.y, cq.z, cq.w};
#pragma unroll
  for (int q = 0; q < 12; ++q) {
    svT[(24 * w + 2 * q) * 72 + lane] = (u16)(wv[q] & 0xffffu);
    svT[(24 * w + 2 * q + 1) * 72 + lane] = (u16)(wv[q] >> 16);
  }
}

__device__ void gla_g1_unit(const Params& P, int l, int unit, float* sm) {
  const int tid = get_tid(), lane = tid & 63, w = __builtin_amdgcn_readfirstlane(tid >> 6), g = lane >> 4, li = lane & 15;
  int chain = unit / NCH, n = unit % NCH;
  int b = chain >> 3, h = (chain >> 1) & 3, dir = chain & 1;
  int c = (dir == 0) ? n : (n < 4 ? 3 - n : 39 - n);
  u16* svT = (u16*)sm;
  u16* skT = svT + 96 * 72;
  __syncthreads();
  gla_load_vT(P, b, h, c, svT);
  gla_prep<0>(P, l, b, h, c, dir, skT, nullptr, P.dec + (size_t)unit * 48, sm + 8192, P.gb + (size_t)unit * 3072);
  __syncthreads();
  u16* kvp = P.kv + (size_t)unit * 4608;
  for (int vt = w; vt < 6; vt += 4) {
    f32x4 acc[3];
#pragma unroll
    for (int j = 0; j < 3; ++j) acc[j] = f32x4{0.f, 0.f, 0.f, 0.f};
#pragma unroll
    for (int ks = 0; ks < 2; ++ks) {
      bf16x8 af = *(const bf16x8*)(svT + (vt * 16 + li) * 72 + ks * 32 + g * 8);
#pragma unroll
      for (int j = 0; j < 3; ++j) {
        bf16x8 bfv = *(const bf16x8*)(skT + (j * 16 + li) * 72 + ks * 32 + g * 8);
        acc[j] = __builtin_amdgcn_mfma_f32_16x16x32_bf16(af, bfv, acc[j], 0, 0, 0);
      }
    }
#pragma unroll
    for (int j = 0; j < 3; ++j)
#pragma unroll
      for (int e = 0; e < 4; ++e) kvp[(vt * 16 + g * 4 + e) * 48 + j * 16 + li] = f2bf(acc[j][e]);
  }
}

__device__ void gla_g2(const Params& P, int idx) {
  int chain = idx / 4608, e = idx % 4608, kk = e % 48;
  u16* kp = P.kv + (size_t)chain * NCH * 4608 + e;
  const float* dp = P.dec + (size_t)chain * NCH * 48 + kk;
  float kvv[NCH], dd[NCH];
#pragma unroll
  for (int n = 0; n < NCH; ++n) { kvv[n] = bf2f(kp[(size_t)n * 4608]); dd[n] = dp[n * 48]; }
  float S = 0.f;
#pragma unroll
  for (int n = 0; n < NCH; ++n) {
    kp[(size_t)n * 4608] = f2bf(S);
    S = dd[n] * S + kvv[n];
  }
}

__device__ void gla_g3_unit(const Params& P, int l, int unit, float* sm) {
  const int tid = get_tid(), lane = tid & 63, w = __builtin_amdgcn_readfirstlane(tid >> 6), g = lane >> 4, li = lane & 15;
  int c = unit % NCH, h = (unit / NCH) & 3, b = unit / (NCH * 4);
  u16* svT = (u16*)sm;
  u16* sqd = svT + 96 * 72;
  u16* skd = sqd + 64 * 72;
  __syncthreads();
  gla_load_vT(P, b, h, c, svT);
  for (int i = tid; i < 64 * 8; i += NTHREADS) {
    int r = i >> 3, q = i & 7;
    *(unsigned*)(sqd + r * 72 + 48 + 2 * q) = 0u;
    *(unsigned*)(skd + r * 72 + 48 + 2 * q) = 0u;
  }
  f32x4 o[6];
#pragma unroll
  for (int vt = 0; vt < 6; ++vt) o[vt] = f32x4{0.f, 0.f, 0.f, 0.f};
  const int tkq = 16 * w + li;
#pragma unroll 1
  for (int dir = 0; dir < 2; ++dir) {
    const int chain = (b * 4 + h) * 2 + dir;
    const int n = (dir == 0) ? c : (c < 4 ? 3 - c : 39 - c);
    const u16* Sp = P.kv + ((size_t)chain * NCH + n) * 4608;
    bf16x8 sfa[6], sfb[6];
#pragma unroll
    for (int vt = 0; vt < 6; ++vt) {
      const u16* sp = Sp + (vt * 16 + li) * 48 + g * 8;
      sfa[vt] = *(const bf16x8*)(sp);
      u32x4 zz = u32x4{0u, 0u, 0u, 0u};
      sfb[vt] = __builtin_bit_cast(bf16x8, zz);
      if (g < 2) sfb[vt] = *(const bf16x8*)(sp + 32);
    }
    gla_prep<1>(P, l, b, h, c, dir, sqd, skd, nullptr, sm + 8192, P.gb + ((size_t)chain * NCH + n) * 3072);
    __syncthreads();
    const bf16x8 q0 = *(const bf16x8*)(sqd + tkq * 72 + g * 8);
    const bf16x8 q1 = *(const bf16x8*)(sqd + tkq * 72 + 32 + g * 8);
    f32x4 st[4];
#pragma unroll
    for (int t = 0; t < 4; ++t) {
      f32x4 a = f32x4{0.f, 0.f, 0.f, 0.f};
      const bool need = dir ? (t >= w) : (t <= w);
      if (need) {
        bf16x8 k0 = *(const bf16x8*)(skd + (t * 16 + li) * 72 + g * 8);
        bf16x8 k1 = *(const bf16x8*)(skd + (t * 16 + li) * 72 + 32 + g * 8);
        a = __builtin_amdgcn_mfma_f32_16x16x32_bf16(k0, q0, a, 0, 0, 0);
        a = __builtin_amdgcn_mfma_f32_16x16x32_bf16(k1, q1, a, 0, 0, 0);
#pragma unroll
        for (int e = 0; e < 4; ++e) {
          int sidx = t * 16 + g * 4 + e;
          bool valid = dir ? (sidx >= tkq) : (sidx <= tkq);
          a[e] = valid ? a[e] : 0.f;
        }
      }
      st[t] = a;
    }
#pragma unroll
    for (int pr = 0; pr < 2; ++pr) {
      u32x4 pu;
      pu[0] = pack2(st[2 * pr][0], st[2 * pr][1]);
      pu[1] = pack2(st[2 * pr][2], st[2 * pr][3]);
      pu[2] = pack2(st[2 * pr + 1][0], st[2 * pr + 1][1]);
      pu[3] = pack2(st[2 * pr + 1][2], st[2 * pr + 1][3]);
      const bf16x8 pfv = __builtin_bit_cast(bf16x8, pu);
#pragma unroll
      for (int vt = 0; vt < 6; ++vt) {
        const u16* vp = svT + (vt * 16 + li) * 72 + pr * 32 + g * 4;
        uint2 va = *(const uint2*)(vp);
        uint2 vb = *(const uint2*)(vp + 16);
        u32x4 vu; vu[0] = va.x; vu[1] = va.y; vu[2] = vb.x; vu[3] = vb.y;
        o[vt] = __builtin_amdgcn_mfma_f32_16x16x32_bf16(__builtin_bit_cast(bf16x8, vu), pfv, o[vt], 0, 0, 0);
      }
    }
#pragma unroll
    for (int vt = 0; vt < 6; ++vt) {
      o[vt] = __builtin_amdgcn_mfma_f32_16x16x32_bf16(sfa[vt], q0, o[vt], 0, 0, 0);
      o[vt] = __builtin_amdgcn_mfma_f32_16x16x32_bf16(sfb[vt], q1, o[vt], 0, 0, 0);
    }
    __syncthreads();
  }
  float ss = 0.f;
#pragma unroll
  for (int vt = 0; vt < 6; ++vt)
#pragma unroll
    for (int e = 0; e < 4; ++e) ss += o[vt][e] * o[vt][e];
  ss += __shfl_xor(ss, 16);
  ss += __shfl_xor(ss, 32);
  const float rstd = rsqrtf(ss * (1.f / 96.f) + 1e-6f);
  const int row = gla_tok_row(b, c, tkq);
  const float* gw = P.gnw + l * 96;
#pragma unroll
  for (int vt = 0; vt < 6; ++vt) {
    int vv = vt * 16 + g * 4;
    uint2 gg = *(const uint2*)(P.proj + (size_t)row * PSTR + C_GG + h * 96 + vv);
    float4 gwv = *(const float4*)(gw + vv);
    float g0 = bf2f((u16)(gg.x & 0xffff)), g1 = bf2f((u16)(gg.x >> 16)), g2 = bf2f((u16)(gg.y & 0xffff)), g3 = bf2f((u16)(gg.y >> 16));
    float o0 = o[vt][0] * rstd * gwv.x * silu(g0), o1 = o[vt][1] * rstd * gwv.y * silu(g1);
    float o2 = o[vt][2] * rstd * gwv.z * silu(g2), o3 = o[vt][3] * rstd * gwv.w * silu(g3);
    *(uint2*)(P.hx + (size_t)row * 1024 + 640 + h * 96 + vv) = make_uint2(pack2(o0, o1), pack2(o2, o3));
  }
}

constexpr int P4_NFX = NB * 16 * 2;
constexpr int NA_PER_IDLE = 2;
__device__ __forceinline__ int na_total(bool last) { return NB * 32 * 6 + (last ? 0 : NB * 6 * 4); }
__device__ __forceinline__ int p4_nfc(bool last) { return last ? 0 : NB * 2 * 2; }
__device__ __forceinline__ int na_p4_count(int nb, bool last) {
  const int n_idle = nb > P4_NFX ? nb - P4_NFX : 0, nfc = p4_nfc(last);
  const int a = n_idle < nfc ? n_idle : nfc;
  int c = (NA_PER_IDLE - 1) * a + NA_PER_IDLE * (n_idle - a);
  const int tot = na_total(last);
  return c < tot ? c : tot;
}
__device__ __forceinline__ void na_any(const Params& P, int l, int id, float* sm) {
  const int n_na = NB * 32 * 6;
  if (id < n_na) na_unit<true>(P, l, id, sm); else na_unit<false>(P, l, id - n_na, sm);
}

__device__ void phase3(const Params& P, int l, int bid, int nb, float* sm, int mask) {
  const bool last = (l == DEPTH - 1);
  const int n_cut = na_total(last) - na_p4_count(nb, last);
  const int n_g1 = NUNIT_G;
  const int n_f1 = (last ? (NX + 191) / 192 : NT / 192) * 4;
  const int total = n_cut + n_g1 + n_f1;
  for (int u = bid; u < total; u += nb) {
    int v = u;
    if (v < n_cut) { if (mask & 1) na_any(P, l, v, sm); continue; }
    v -= n_cut;
    if (v < n_g1) { if (mask & 2) gla_g1_unit(P, l, v, sm); continue; }
    v -= n_g1;
    if (mask & 4) {
      int mt = v >> 2, gq = v & 3;
      u16* const vtx = P.vtx; u16* const vtc = P.vtc;
      gemm_tile<192, 0>(P.proj + C_FIN + gq * 64, PSTR, P.dft64, 64, 64, mt * 192, 0, (u16*)sm, [=](int m, int n, f32x4 val) {
        int part = n >> 6, j = n & 63;
        if (m < NX) {
          int b = m >> 11, t = m & 2047;
          u16* d = vtx + ((size_t)(b * 256 + gq * 64 + j)) * 4096 + part * 2048 + t;
#pragma unroll
          for (int q = 0; q < 4; ++q) d[(size_t)q * 4096] = f2bf(val[q]);
        } else {
          int mc = m - NX, b = mc >> 8, t = mc & 255;
          u16* d = vtc + ((size_t)(b * 256 + gq * 64 + j)) * 512 + part * 256 + t;
#pragma unroll
          for (int q = 0; q < 4; ++q) d[(size_t)q * 512] = f2bf(val[q]);
        }
      });
    }
  }
}

__device__ void phase4(const Params& P, int l, int bid, int nb, float* sm, int noscan) {
  const bool last = (l == DEPTH - 1);
  const int n_fx = P4_NFX;
  const int n_fc = p4_nfc(last);
  const int n_sc = (64 * 4608) / NTHREADS;
  const int n_idle = nb > n_fx ? nb - n_fx : 0;
  u16* const proj = P.proj;
  for (int v = bid; v < n_fx; v += nb) {
    int b = v >> 5, mt = (v >> 1) & 15, nt = v & 1;
    gemm_tile<128, 0>(P.dftL, 4096, P.vtx + (size_t)b * 256 * 4096, 4096, 4096, mt * 128, nt * 128, (u16*)sm, [=](int m, int n, f32x4 val) {
      *(uint2*)(proj + (size_t)(b * 2048 + m) * PSTR + C_FIN + n) = make_uint2(pack2(val[0], val[1]), pack2(val[2], val[3]));
    });
  }
  {
    const int j = bid - n_fx;
    const int jj = (n_idle > 0) ? j : bid, jstride = (n_idle > 0) ? n_idle : nb;
    if (n_idle == 0 || j >= 0) {
      for (int v = jj; v < n_fc; v += jstride) {
        int b = v >> 2, mt = (v >> 1) & 1, nt = v & 1;
        gemm_tile<128, 0>(P.dftC, 512, P.vtc + (size_t)b * 256 * 512, 512, 512, mt * 128, nt * 128, (u16*)sm, [=](int m, int n, f32x4 val) {
          *(uint2*)(proj + (size_t)(NX + b * 256 + m) * PSTR + C_FIN + n) = make_uint2(pack2(val[0], val[1]), pack2(val[2], val[3]));
        });
      }
    }
    if (!noscan && j >= 0) {
      const int tot = na_total(last), cut = tot - na_p4_count(nb, last);
      const int a = n_idle < n_fc ? n_idle : n_fc;
      const int nmine = (j < a) ? NA_PER_IDLE - 1 : NA_PER_IDLE;
      const int base = cut + ((j < a) ? (NA_PER_IDLE - 1) * j : (NA_PER_IDLE - 1) * a + NA_PER_IDLE * (j - a));
      for (int q = 0; q < nmine; ++q) { const int id = base + q; if (id < tot) na_any(P, l, id, sm); }
    }
  }
  if (!noscan) for (int v = bid; v < n_sc; v += nb) gla_g2(P, v * NTHREADS + get_tid());
}

__device__ void phase5(const Params& P, int l, int bid, int nb, float* sm) {
  const bool last = (l == DEPTH - 1);
  const int n_g3 = NB * 4 * NCH;
  const int n_w4 = (last ? (NX + 191) / 192 : NT / 192) * 2;
  const int total = n_g3 + n_w4;
  for (int u = bid; u < total; u += nb) {
    int v = u;
    if (v < n_g3) {
      int c = v % NCH;
      if (last && c < 4) continue;
      gla_g3_unit(P, l, v, sm);
      continue;
    }
    v -= n_g3;
    int mt = v >> 1, nt = v & 1;
    u16* const proj = P.proj; u16* const mix = P.hx;
    gemm_tile<192, 0>(P.proj + C_FIN, PSTR, P.wtfour, 256, 256, mt * 192, nt * 128, (u16*)sm, [=](int m, int n, f32x4 val) {
      if (last && m >= NX) return;
      uint2 gg = *(const uint2*)(proj + (size_t)m * PSTR + C_FG + n);
      float g0 = bf2f((u16)(gg.x & 0xffff)), g1 = bf2f((u16)(gg.x >> 16)), g2 = bf2f((u16)(gg.y & 0xffff)), g3 = bf2f((u16)(gg.y >> 16));
      *(uint2*)(mix + (size_t)m * 1024 + n) = make_uint2(pack2(val[0] * silu(g0), val[1] * silu(g1)), pack2(val[2] * silu(g2), val[3] * silu(g3)));
    });
  }
}

__device__ void phase6(const Params& P, int l, int bid, int nb, float* sm, int skip_epi) {
  const bool last = (l == DEPTH - 1);
  const int nmt = last ? (NX + 191) / 192 : NT / 192;
  const int total = nmt * 8;
  for (int u = bid; u < total; u += nb) {
    int mt = u >> 3, nt = u & 7;
    const float* const modl = P.mod + (size_t)l * 9 * 3072;
    const float* const xs = (l == 0 ? P.x : P.out); const float* const cs = (l == 0 ? P.ctx : P.ctxw);
    float* const xo = P.out; float* const co = P.ctxw;
    gemm_tile<192, 0>(P.hx, 1024, P.wtout, 1024, 1024, mt * 192, nt * 128, (u16*)sm, [=](int m, int n, f32x4 val) {
      if (skip_epi && val[0] != 12345.678f) return;
      if (last && m >= NX) return;
      int s = (m < NX) ? (m >> 11) : 8;
      float4 gt = *(const float4*)(modl + (size_t)s * 3072 + 2048 + n);
      const float* src; float* dst;
      if (m < NX) { src = xs + (size_t)m * 1024 + n; dst = xo + (size_t)m * 1024 + n; }
      else { src = cs + (size_t)(m - NX) * 1024 + n; dst = co + (size_t)(m - NX) * 1024 + n; }
      float4 xv = *(const float4*)src;
      float4 r = make_float4(xv.x + gt.x * val[0], xv.y + gt.y * val[1], xv.z + gt.z * val[2], xv.w + gt.w * val[3]);
      *(float4*)dst = r;
    });
  }
}

__device__ void phasef(const Params& P, int bid, int nb) {
  const int tid = get_tid(), lane = tid & 63, w = tid >> 6;
  for (int row0 = (bid * 4 + w) * 4; row0 < NX; row0 += nb * 16) {
    float* src = P.out + (size_t)row0 * 1024;
    float4 v[4][4];
#pragma unroll
    for (int rr = 0; rr < 4; ++rr)
#pragma unroll
      for (int p = 0; p < 4; ++p) v[rr][p] = *(const float4*)(src + rr * 1024 + (p * 64 + lane) * 4);
    float rstd[4];
#pragma unroll
    for (int rr = 0; rr < 4; ++rr) {
      float ss = 0.f;
#pragma unroll
      for (int p = 0; p < 4; ++p) ss += v[rr][p].x * v[rr][p].x + v[rr][p].y * v[rr][p].y + v[rr][p].z * v[rr][p].z + v[rr][p].w * v[rr][p].w;
      ss = wave_sum(ss);
      rstd[rr] = rsqrtf(ss * (1.f / 1024.f) + 1e-6f);
    }
#pragma unroll
    for (int p = 0; p < 4; ++p) {
      int c0 = (p * 64 + lane) * 4;
      float4 wv = *(const float4*)(P.norm_f + c0);
#pragma unroll
      for (int rr = 0; rr < 4; ++rr)
        *(float4*)(src + rr * 1024 + c0) = make_float4(v[rr][p].x * rstd[rr] * wv.x, v[rr][p].y * rstd[rr] * wv.y, v[rr][p].z * rstd[rr] * wv.z, v[rr][p].w * rstd[rr] * wv.w);
    }
  }
}

__global__ void __launch_bounds__(NTHREADS, 2) mega(Params P, int ph_lo, int ph_hi, int coop) {
  extern __shared__ __attribute__((aligned(16))) unsigned char lds[];
  float* sm = (float*)lds;
  cg::grid_group grid = cg::this_grid();
  const int bid = blockIdx.x, nb = gridDim.x;
  XcdBarrier xb = xcd_barrier_post(P.bar, (unsigned*)lds);
  int vbid = bid;
  for (int ph = ph_lo; ph < ph_hi; ++ph) {
    if (ph == 0) phase0(P, bid, nb, sm);
    else if (ph == 1 + 6 * DEPTH) phasef(P, bid, nb);
    else {
      int l = (ph - 1) / 6, sub = (ph - 1) % 6;
      if (ph == 1) vbid = xcd_vbid(xb);
      for (int rep = 0; rep < ((sub == REP_SUB) ? 2 : 1); ++rep) {
      if (rep) xcd_barrier(xb);
      switch (sub) {
        case 0: phase1(P, l, bid, nb, sm); break;
        case 1: phase2(P, vbid, nb, (u16*)sm, (PROBE_SKIP_EPI && rep) ? 1 : 0); break;
        case 2: phase3(P, l, vbid, nb, sm, rep ? PROBE_MASK : 7); break;
        case 3: phase4(P, l, bid, nb, sm, rep); break;
        case 4: phase5(P, l, bid, nb, sm); break;
        case 5: phase6(P, l, vbid, nb, sm, rep); break;
        default: break;
      }
      }
    }
    if (coop && ph + 1 < ph_hi) { if (coop == 2) grid.sync(); else xcd_barrier(xb); for (int e = 0; e < EXTRA_SYNCS; ++e) xcd_barrier(xb); }
  }
}

extern "C" void kernel_launch(void* const* d_in, const int* in_sizes, int n_in, void* d_out, int out_size, void* d_ws,
                              size_t ws_size, hipStream_t stream) {
  static int grid_blocks = 0;
  if (grid_blocks == 0) {
    int dev = 0, cus = 0, per_cu = 0;
    hipGetDevice(&dev);
    hipDeviceGetAttribute(&cus, hipDeviceAttributeMultiprocessorCount, dev);
    if (hipFuncSetAttribute((const void*)mega, hipFuncAttributeMaxDynamicSharedMemorySize, LDS_BYTES) != hipSuccess) {
      fprintf(stderr, "hipFuncSetAttribute failed\n");
    }
    hipOccupancyMaxActiveBlocksPerMultiprocessor(&per_cu, (const void*)mega, NTHREADS, LDS_BYTES);
    if (per_cu < 1) { fprintf(stderr, "occupancy query returned %d\n", per_cu); per_cu = 1; }
    if (per_cu > 2) per_cu = 2;
    grid_blocks = cus * per_cu;
  }
  Params P{};
  const float* const* in = (const float* const*)d_in;
  P.x = in[0]; P.c = in[1]; P.ctx = in[2]; P.c_ctx = in[3]; P.w_ada = in[4]; P.b_ada = in[5]; P.norm_w = in[6];
  P.w_in = in[7]; P.w_four = in[8]; P.rpb = in[9]; P.waf = in[10]; P.baf = in[11]; P.wab = in[12]; P.bab = in[13];
  P.gnw = in[14]; P.w_out = in[15]; P.norm_f = in[16];
  P.out = (float*)d_out;
  size_t off = 0;
  auto take = [&](size_t bytes) { void* p = (char*)d_ws + off; off += (bytes + 255) & ~(size_t)255; return p; };
  P.mod = (float*)take((size_t)4 * 9 * 3072 * 4);
  P.ropecs = (float*)take((size_t)2048 * 24 * 2 * 4);
  P.dft64 = (u16*)take((size_t)128 * 64 * 2);
  P.dftC = (u16*)take((size_t)256 * 512 * 2);
  P.dftL = (u16*)take((size_t)2048 * 4096 * 2);
  P.wtin = (u16*)take((size_t)DINP * 1024 * 2);
  P.wtout = (u16*)take((size_t)1024 * 1024 * 2);
  P.wtfour = (u16*)take((size_t)256 * 256 * 2);
  P.hx = (u16*)take((size_t)NT * 1024 * 2);
  P.proj = (u16*)take((size_t)NT * PSTR * 2);
  P.vtx = (u16*)take((size_t)8 * 256 * 4096 * 2);
  P.vtc = (u16*)take((size_t)8 * 256 * 512 * 2);
  P.natvx = (u16*)take((size_t)8 * 384 * 2048 * 2);
  P.natvc = (u16*)take((size_t)8 * 384 * 256 * 2);
  P.natkx = (u16*)take((size_t)8 * 384 * 2048 * 2);
  P.natkc = (u16*)take((size_t)8 * 384 * 256 * 2);
  P.ctxw = (float*)take((size_t)NC * 1024 * 4);
  P.kv = (u16*)take((size_t)NUNIT_G * 4608 * 2);
  P.dec = (float*)take((size_t)NUNIT_G * 48 * 4);
  P.gb = (float*)take((size_t)NUNIT_G * 3072 * 4);
  P.bar = (unsigned*)take((size_t)XCD_BAR_WORDS * 4);
  if (off > ws_size) { fprintf(stderr, "workspace too small: need %zu have %zu\n", off, ws_size); return; }
  if (hipMemsetAsync(P.bar, 0, (size_t)XCD_BAR_WORDS * 4, stream) != hipSuccess) { fprintf(stderr, "memset of barrier words failed\n"); return; }
  int ph_lo = 0, ph_hi = 2 + 6 * DEPTH, coop = 1;
  void* args[] = {&P, &ph_lo, &ph_hi, &coop};
  hipError_t e = hipLaunchCooperativeKernel((const void*)mega, dim3(grid_blocks), dim3(NTHREADS), args, LDS_BYTES, stream);
  if (e != hipSuccess) fprintf(stderr, "cooperative launch failed: %s (grid %d)\n", hipGetErrorString(e), grid_blocks);
}
```

```cpp
#include <hip/hip_runtime.h>
#include <hip/hip_bf16.h>
#include <hip/hip_cooperative_groups.h>
#include <cstdio>
namespace cg = cooperative_groups;

typedef unsigned short u16;
using bf16x8 = __attribute__((ext_vector_type(8))) short;
using f32x4 = __attribute__((ext_vector_type(4))) float;
using u32x4 = __attribute__((ext_vector_type(4))) unsigned;

#define NTHREADS 256
#define REP_SUB 100
#define EXTRA_SYNCS 0
#define PROBE_SKIP_EPI 0
#define PROBE_MASK 7
#define LDS_BYTES 81920

constexpr int DM = 1024, NB = 8, SEQ = 2048, DEPTH = 4, CTXL = 256;
constexpr int NX = NB * SEQ;
constexpr int NC = NB * CTXL;
constexpr int NT = NX + NC;
constexpr int DIN = 3232, DINP = 3328;
constexpr int N_NK = 896, N_NV = 1280, N_NG = 1664;
constexpr int PSTR = DIN - 768;
constexpr int C_FIN = 0, C_FG = 256, C_NQ = 512, C_NG = 896;
constexpr int C_GQ = 1280, C_GK = 1472, C_GV = 1664, C_GG = 2048, C_ZF = 2432, C_ZB = 2448;
constexpr int NCH = 36;
constexpr int NUNIT_G = NB * 4 * 2 * NCH;

struct Params {
  const float *x, *c, *ctx, *c_ctx, *w_ada, *b_ada, *norm_w, *w_in, *w_four, *rpb;
  const float *waf, *baf, *wab, *bab, *gnw, *w_out, *norm_f;
  float* out;
  float* mod;
  float* ropecs;
  u16* dft64;
  u16* dftC;
  u16* dftL;
  u16* wtin;
  u16* wtout;
  u16* wtfour;
  u16* hx;
  u16* proj;
  u16* vtx;
  u16* vtc;
  u16* natvx;
  u16* natvc;
  u16* natkx;
  u16* natkc;
  float* ctxw;
  u16* kv;
  float* dec;
  float* gb;
  unsigned* bar;
};

__device__ __forceinline__ int get_tid() { int t = threadIdx.x; asm volatile("" : "+v"(t)); return t; }
typedef __bf16 hbf16x2 __attribute__((ext_vector_type(2)));
typedef float hf32x2 __attribute__((ext_vector_type(2)));
__device__ __forceinline__ u16 f2bf(float f) { return __builtin_bit_cast(u16, (__bf16)f); }
__device__ __forceinline__ float bf2f(u16 h) { return __uint_as_float(((unsigned)h) << 16); }
__device__ __forceinline__ unsigned pack2(float a, float b) { hf32x2 f = {a, b}; return __builtin_bit_cast(unsigned, __builtin_convertvector(f, hbf16x2)); }
__device__ __forceinline__ float silu(float v) { return v / (1.f + __expf(-v)); }
__device__ __forceinline__ float wave_sum(float v) {
#pragma unroll
  for (int o = 32; o > 0; o >>= 1) v += __shfl_xor(v, o);
  return v;
}

#define XB_TMO      128
#define XB_XCNT(j)  (256  + 64 * (j))
#define XB_XSUB(j)  (1280 + 64 * (j))
#define XB_XGEN(j)  (2304 + 64 * (j))
#define XB_TOP      3328
#define XB_TOPGEN   3392
#define XCD_BAR_WORDS 3456
#define XB_SPIN_CAP (1u << 20)
#define LAS __attribute__((address_space(3)))
__device__ __forceinline__ unsigned xb_ld(unsigned* p)              { return __hip_atomic_load(p, __ATOMIC_RELAXED, __HIP_MEMORY_SCOPE_AGENT); }
__device__ __forceinline__ unsigned xb_add(unsigned* p, unsigned v) { return __hip_atomic_fetch_add(p, v, __ATOMIC_RELAXED, __HIP_MEMORY_SCOPE_AGENT); }
__device__ __forceinline__ unsigned xb_xcc_id() { return (unsigned)__builtin_amdgcn_s_getreg((3 << 11) | 20) & 0xFu; }
#define XB_SPIN(cond, bar) do { unsigned _sp = 0; while (cond) { __builtin_amdgcn_s_sleep(1); \
    if ((++_sp & 255u) == 0u) { if (xb_ld(&(bar)[XB_TMO])) break; if (_sp > XB_SPIN_CAP) { atomicAdd(&(bar)[XB_TMO], 1u); break; } } } } while (0)
struct XcdBarrier { unsigned* bar; unsigned x; unsigned nloc, nx, rank; };
__device__ __forceinline__ XcdBarrier xcd_barrier_post(unsigned* bar, unsigned* lds_word) {
  XcdBarrier b; b.bar = bar; b.x = xb_xcc_id(); b.nloc = 0u; b.nx = 0u;
  if (threadIdx.x == 0) *lds_word = xb_add(&bar[XB_XCNT(b.x)], 1u);
  __syncthreads();
  b.rank = *(volatile unsigned*)lds_word;
  __syncthreads();
  return b;
}
__device__ __forceinline__ void xcd_barrier_complete(unsigned* bar, unsigned x, unsigned& nloc, unsigned& nx) {
  const unsigned G = gridDim.x * gridDim.y * gridDim.z;
  unsigned sum, cnt, mine, sp = 0u;
  for (;;) {
    sum = 0u; cnt = 0u; mine = 0u;
#pragma unroll
    for (unsigned j = 0; j < 16; ++j) { const unsigned c = xb_ld(&bar[XB_XCNT(j)]); sum += c; cnt += (c > 0u) ? 1u : 0u; mine = (j == x) ? c : mine; }
    if (sum == G) break;
    __builtin_amdgcn_s_sleep(1);
    if ((++sp & 255u) == 0u) { if (xb_ld(&bar[XB_TMO])) break; if (sp > XB_SPIN_CAP) { atomicAdd(&bar[XB_TMO], 1u); break; } }
  }
  nloc = mine > 0u ? mine : 1u; nx = cnt > 0u ? cnt : 1u;
}
__device__ __forceinline__ void xcd_barrier(XcdBarrier& b) {
  asm volatile("s_waitcnt vmcnt(0)" ::: "memory");
  __syncthreads();
  if (threadIdx.x == 0) {
    unsigned* bar = b.bar;
    __builtin_amdgcn_s_waitcnt(0);
    unsigned nloc = b.nloc, nx = b.nx;
    if (nloc == 0u) { xcd_barrier_complete(bar, b.x, nloc, nx); b.nloc = nloc; b.nx = nx; }
    const unsigned old = xb_add(&bar[XB_XSUB(b.x)], 1u);
    const unsigned gen = old / nloc;
    if (old + 1u == (gen + 1u) * nloc) {
      __builtin_amdgcn_fence(__ATOMIC_RELEASE, "agent");
      asm volatile("s_waitcnt vmcnt(0)" ::: "memory");
      const unsigned og = xb_add(&bar[XB_TOP], 1u);
      const unsigned tg = og / nx;
      if (og + 1u == (tg + 1u) * nx) xb_add(&bar[XB_TOPGEN], 1u);
      else XB_SPIN(xb_ld(&bar[XB_TOPGEN]) == tg, bar);
      __builtin_amdgcn_fence(__ATOMIC_ACQUIRE, "agent");
      xb_add(&bar[XB_XGEN(b.x)], 1u);
      asm volatile("s_waitcnt vmcnt(0)" ::: "memory");
    } else {
      XB_SPIN(xb_ld(&bar[XB_XGEN(b.x)]) == gen, bar);
      __builtin_amdgcn_fence(__ATOMIC_ACQUIRE, "agent");
      asm volatile("s_waitcnt vmcnt(0)" ::: "memory");
    }
  }
  __syncthreads();
}

__device__ __forceinline__ int xcd_vbid(const XcdBarrier& b) {
  unsigned pre = 0;
#pragma unroll
  for (unsigned j = 0; j < 16; ++j) { const unsigned c = xb_ld(&b.bar[XB_XCNT(j)]); pre += (j < b.x) ? c : 0u; }
  return (int)(pre + b.rank);
}

template <int BM, int WIDE, class Epi>
__device__ __forceinline__ void gemm_tile(const u16* __restrict__ A, int lda, const u16* __restrict__ Bt, int ldb,
                                          int K, int m0, int n0, u16* smem, Epi epi) {
  constexpr int MI = BM / 32;
  constexpr int BUF = (BM + 128) * 64;
  const int tid = get_tid(), lane = tid & 63, w = tid >> 6;
  const int wm = w >> 1, wn = w & 1;
  f32x4 acc[MI][4];
#pragma unroll
  for (int i = 0; i < MI; ++i)
#pragma unroll
    for (int j = 0; j < 4; ++j) acc[i][j] = f32x4{0.f, 0.f, 0.f, 0.f};
  const int nk = K >> 6;
  const int srow = lane >> 3;
  const int schunk = (lane & 7) ^ (((w * 8 + srow) >> 1) & 7);
  const u16* ga = A + (size_t)(m0 + w * 8 + srow) * lda + schunk * 8;
  const u16* gb = Bt + (size_t)(n0 + w * 8 + srow) * ldb + schunk * 8;
  const size_t sa32 = (size_t)32 * lda, sb32 = (size_t)32 * ldb;
  const int woff = (w * 8) * 64 + lane * 8;
  const int rsw = ((lane & 15) >> 1) & 7;
  const int c0 = (((lane >> 4)) ^ rsw) * 8, c1 = ((4 + (lane >> 4)) ^ rsw) * 8;
  const int roffA = (wm * (BM / 2) + (lane & 15)) * 64;
  const int brow = WIDE ? (((((lane & 15) >> 2) & 1) * 2 + ((lane & 15) >> 3)) * 4 + (lane & 3)) : (lane & 15);
  const int rswB = (brow >> 1) & 7;
  const int c0B = (((lane >> 4)) ^ rswB) * 8, c1B = ((4 + (lane >> 4)) ^ rswB) * 8;
  const int roffB = BM * 64 + (wn * 64 + brow) * 64;
#define GLDS(gp, lp) __builtin_amdgcn_global_load_lds((const unsigned*)(gp), (unsigned*)(lp), 16, 0, 0)
#define G_ISSUE(buf, koff) { u16* _w = (buf) + woff; \
    _Pragma("unroll") for (int p = 0; p < MI; ++p) GLDS(ga + (koff) + p * sa32, _w + p * 32 * 64); \
    _w += BM * 64; \
    _Pragma("unroll") for (int p = 0; p < 4; ++p) GLDS(gb + (koff) + p * sb32, _w + p * 32 * 64); }
#define RAW_BARRIER() do { asm volatile("s_waitcnt lgkmcnt(0)" ::: "memory"); __builtin_amdgcn_s_barrier(); asm volatile("" ::: "memory"); } while (0)
  __syncthreads();
  G_ISSUE(smem, 0);
  if (nk > 1) G_ISSUE(smem + BUF, 64);
  for (int kt = 0; kt < nk; ++kt) {
    u16* cur = smem + (kt & 1) * BUF;
    if (kt + 1 < nk) {
      if (MI == 4) asm volatile("s_waitcnt vmcnt(8)" ::: "memory"); else asm volatile("s_waitcnt vmcnt(10)" ::: "memory");
    } else asm volatile("s_waitcnt vmcnt(0)" ::: "memory");
    RAW_BARRIER();
    __builtin_amdgcn_sched_barrier(0);
    bf16x8 af[2][MI], bfr[2][4];
#pragma unroll
    for (int i = 0; i < MI; ++i) af[0][i] = *(const bf16x8*)(cur + roffA + i * 16 * 64 + c0);
#pragma unroll
    for (int i = 0; i < 4; ++i) bfr[0][i] = *(const bf16x8*)(cur + roffB + i * 16 * 64 + c0B);
#pragma unroll
    for (int i = 0; i < MI; ++i) af[1][i] = *(const bf16x8*)(cur + roffA + i * 16 * 64 + c1);
#pragma unroll
    for (int i = 0; i < 4; ++i) bfr[1][i] = *(const bf16x8*)(cur + roffB + i * 16 * 64 + c1B);
    __builtin_amdgcn_sched_barrier(0);
    RAW_BARRIER();
    __builtin_amdgcn_sched_barrier(0);
    if (kt + 2 < nk) G_ISSUE(cur, (size_t)(kt + 2) * 64);
    __builtin_amdgcn_sched_barrier(0);
#pragma unroll
    for (int ks = 0; ks < 2; ++ks)
#pragma unroll
      for (int i = 0; i < MI; ++i)
#pragma unroll
        for (int j = 0; j < 4; ++j)
          acc[i][j] = __builtin_amdgcn_mfma_f32_16x16x32_bf16(bfr[ks][j], af[ks][i], acc[i][j], 0, 0, 0);
  }
#undef RAW_BARRIER
#undef GLDS
#undef G_ISSUE
  __syncthreads();
  if constexpr (WIDE) {
    const int g = lane >> 4;
#pragma unroll
    for (int i = 0; i < MI; ++i)
#pragma unroll
      for (int jp = 0; jp < 2; ++jp) {
        unsigned ax = pack2(acc[i][2 * jp][0], acc[i][2 * jp][1]), ay = pack2(acc[i][2 * jp][2], acc[i][2 * jp][3]);
        unsigned bx = pack2(acc[i][2 * jp + 1][0], acc[i][2 * jp + 1][1]), by = pack2(acc[i][2 * jp + 1][2], acc[i][2 * jp + 1][3]);
        auto rx = __builtin_amdgcn_permlane32_swap(ax, bx, false, false);
        auto ry = __builtin_amdgcn_permlane32_swap(ay, by, false, false);
        const int m = m0 + wm * (BM / 2) + i * 16 + (lane & 15);
        const int n8 = n0 + wn * 64 + (2 * jp + (g >> 1)) * 16 + (g & 1) * 8;
        epi(m, n8, make_uint4(rx[0], ry[0], rx[1], ry[1]));
      }
  } else {
#pragma unroll
    for (int i = 0; i < MI; ++i)
#pragma unroll
      for (int j = 0; j < 4; ++j) {
        int m = m0 + wm * (BM / 2) + i * 16 + (lane & 15);
        int n = n0 + wn * 64 + j * 16 + (lane >> 4) * 4;
        epi(m, n, acc[i][j]);
      }
  }
}

__device__ void tconv_unit(const float* __restrict__ src, int K, int N, u16* __restrict__ dst, int Npad, int unit, float* tile) {
  const int tid = get_tid();
  const int ntn = Npad >> 6;
  const int nt = unit % ntn, kt = unit / ntn;
  const int k0 = kt * 64, n0 = nt * 64;
  __syncthreads();
#pragma unroll
  for (int p = 0; p < 4; ++p) {
    int i = (tid >> 4) + 16 * p, j = (tid & 15) * 4;
    int n = n0 + j;
    float4 v = make_float4(0.f, 0.f, 0.f, 0.f);
    if (n < N) v = *(const float4*)(src + (size_t)(k0 + i) * N + n);
    tile[i * 65 + j + 0] = v.x; tile[i * 65 + j + 1] = v.y; tile[i * 65 + j + 2] = v.z; tile[i * 65 + j + 3] = v.w;
  }
  __syncthreads();
  {
    int nl = tid >> 2, ks = (tid & 3) * 16;
    unsigned pk[8];
#pragma unroll
    for (int q = 0; q < 8; ++q) pk[q] = pack2(tile[(ks + 2 * q) * 65 + nl], tile[(ks + 2 * q + 1) * 65 + nl]);
    u16* d = dst + (size_t)(n0 + nl) * K + k0 + ks;
    *(uint4*)d = make_uint4(pk[0], pk[1], pk[2], pk[3]);
    *(uint4*)(d + 8) = make_uint4(pk[4], pk[5], pk[6], pk[7]);
  }
}

__device__ void phase0(const Params& P, int bid, int nb, float* sm) {
  const int tid = get_tid();
  float* sv = sm;
  float* red = sm + 9216;
  if (bid < 192) {
    for (int i = tid; i < 9 * 1024; i += NTHREADS) {
      int s = i >> 10, k = i & 1023;
      float v = (s < 8) ? P.c[s * 1024 + k] : P.c_ctx[k];
      sv[i] = silu(v);
    }
    __syncthreads();
    for (int unit = bid; unit < 192; unit += nb) {
      int col0 = unit * 64;
      int l = col0 / 3072, n0 = col0 % 3072;
      int kg = tid >> 6, col = tid & 63;
      float acc[9];
#pragma unroll
      for (int s = 0; s < 9; ++s) acc[s] = 0.f;
      const float* wp = P.w_ada + (size_t)l * 1024 * 3072 + n0 + col;
      for (int k0 = kg * 256; k0 < kg * 256 + 256; k0 += 32) {
        float wv[32];
#pragma unroll
        for (int q = 0; q < 32; ++q) wv[q] = wp[(size_t)(k0 + q) * 3072];
#pragma unroll
        for (int q = 0; q < 32; ++q)
#pragma unroll
          for (int s = 0; s < 9; ++s) acc[s] += sv[s * 1024 + k0 + q] * wv[q];
      }
#pragma unroll
      for (int s = 0; s < 9; ++s) red[(kg * 9 + s) * 64 + col] = acc[s];
      __syncthreads();
      for (int o = tid; o < 576; o += NTHREADS) {
        int s = o >> 6, cc = o & 63;
        float v = red[(0 * 9 + s) * 64 + cc] + red[(1 * 9 + s) * 64 + cc] + red[(2 * 9 + s) * 64 + cc] + red[(3 * 9 + s) * 64 + cc];
        P.mod[((size_t)l * 9 + s) * 3072 + n0 + cc] = v + P.b_ada[l * 3072 + n0 + cc];
      }
      __syncthreads();
    }
  }
  const int gtid = bid * NTHREADS + tid, gsz = nb * NTHREADS;
  const float sL = 0.022097086912079608f;
  for (int i8 = gtid; i8 < 2048 * 512; i8 += gsz) {
    int k = i8 >> 9, t0 = (i8 & 511) * 8;
    unsigned pk[4];
#pragma unroll
    for (int j = 0; j < 4; ++j) {
      float v[2];
#pragma unroll
      for (int e = 0; e < 2; ++e) {
        int tc = t0 + 2 * j + e;
        int t = tc & 2047;
        int m = (k * t) & 2047;
        float a = (float)m * (1.f / 1024.f);
        v[e] = (tc < 2048) ? cospif(a) * sL : -sinpif(a) * sL;
      }
      pk[j] = pack2(v[0], v[1]);
    }
    *(uint4*)(P.dftL + (size_t)k * 4096 + t0) = make_uint4(pk[0], pk[1], pk[2], pk[3]);
  }
  for (int i = gtid; i < 256 * 512; i += gsz) {
    int k = i >> 9, tc = i & 511, t = tc & 255;
    int m = (k * t) & 255;
    float a = (float)m * (1.f / 128.f);
    float v = (tc < 256) ? cospif(a) * 0.0625f : -sinpif(a) * 0.0625f;
    P.dftC[i] = f2bf(v);
  }
  for (int i = gtid; i < 128 * 64; i += gsz) {
    int r = i >> 6, cc = i & 63, j = r & 63;
    int m = (j * cc) & 63;
    float a = (float)m * (1.f / 32.f);
    float v = (r < 64) ? cospif(a) * 0.125f : sinpif(a) * 0.125f;
    P.dft64[i] = f2bf(v);
  }
  for (int i = gtid; i < 2048 * 24; i += gsz) {
    int t = i / 24, f = i % 24;
    int fi = f % 12;
    float pos = (f < 12) ? (float)(t >> 6) : (float)(t & 63);
    float inv = powf(10000.f, -(float)fi / 12.f);
    float ang = pos * inv;
    P.ropecs[2 * i] = cosf(ang);
    P.ropecs[2 * i + 1] = sinf(ang);
  }
}

__device__ void phase1(const Params& P, int l, int bid, int nb, float* sm) {
  const int tid = get_tid(), lane = tid & 63, w = tid >> 6;
  const int u_in = 16 * (DINP / 64), u_out = 16 * 16, u_four = 4 * 4;
  for (int u = bid; u < u_in + u_out + u_four; u += nb) {
    if (u < u_in) tconv_unit(P.w_in + (size_t)l * 1024 * DIN, 1024, DIN, P.wtin, DINP, u, sm);
    else if (u < u_in + u_out) tconv_unit(P.w_out + (size_t)l * 1024 * 1024, 1024, 1024, P.wtout, 1024, u - u_in, sm);
    else tconv_unit(P.w_four + (size_t)l * 256 * 256, 256, 256, P.wtfour, 256, u - u_in - u_out, sm);
  }
  const float* nw = P.norm_w + l * 1024;
  for (int row0 = (bid * 4 + w) * 4; row0 < NT; row0 += nb * 16) {
    const float* src;
    int s;
    if (row0 < NX) { src = (l == 0 ? P.x : P.out) + (size_t)row0 * 1024; s = row0 >> 11; }
    else { src = (l == 0 ? P.ctx : P.ctxw) + (size_t)(row0 - NX) * 1024; s = 8; }
    const float* md = P.mod + ((size_t)l * 9 + s) * 3072;
    float4 v[4][4];
#pragma unroll
    for (int rr = 0; rr < 4; ++rr)
#pragma unroll
      for (int p = 0; p < 4; ++p) v[rr][p] = *(const float4*)(src + rr * 1024 + (p * 64 + lane) * 4);
    float rstd[4];
#pragma unroll
    for (int rr = 0; rr < 4; ++rr) {
      float ss = 0.f;
#pragma unroll
      for (int p = 0; p < 4; ++p) ss += v[rr][p].x * v[rr][p].x + v[rr][p].y * v[rr][p].y + v[rr][p].z * v[rr][p].z + v[rr][p].w * v[rr][p].w;
      ss = wave_sum(ss);
      rstd[rr] = rsqrtf(ss * (1.f / 1024.f) + 1e-6f);
    }
#pragma unroll
    for (int p = 0; p < 4; ++p) {
      int c0 = (p * 64 + lane) * 4;
      float4 wv = *(const float4*)(nw + c0);
      float4 sh = *(const float4*)(md + c0);
      float4 sc = *(const float4*)(md + 1024 + c0);
      const float a0 = wv.x * (1.f + sc.x), a1 = wv.y * (1.f + sc.y), a2 = wv.z * (1.f + sc.z), a3 = wv.w * (1.f + sc.w);
#pragma unroll
      for (int rr = 0; rr < 4; ++rr) {
        float o0 = v[rr][p].x * rstd[rr] * a0 + sh.x;
        float o1 = v[rr][p].y * rstd[rr] * a1 + sh.y;
        float o2 = v[rr][p].z * rstd[rr] * a2 + sh.z;
        float o3 = v[rr][p].w * rstd[rr] * a3 + sh.w;
        *(uint2*)(P.hx + (size_t)(row0 + rr) * 1024 + c0) = make_uint2(pack2(o0, o1), pack2(o2, o3));
      }
    }
  }
}

__device__ void phase2(const Params& P, int bid, int nb, u16* sm, int skip_epi) {
  const int ntn = DINP / 128;
  constexpr int NMT = NT / 192;
  const int total = NMT * ntn;
  for (int L = bid; L < total; L += nb) {
    int mt, nt;
    if (L < NMT * 24) { int band = L / (NMT * 8), q = L % (NMT * 8); mt = q >> 3; nt = band * 8 + (q & 7); }
    else { int q = L - NMT * 24; mt = q >> 1; nt = 24 + (q & 1); }
    u16* const proj = P.proj; u16* const natvx = P.natvx; u16* const natvc = P.natvc; u16* const natkx = P.natkx; u16* const natkc = P.natkc;
    gemm_tile<192, 1>(P.hx, 1024, P.wtin, 1024, 1024, mt * 192, nt * 128, sm, [=](int m, int n, uint4 pk) {
      if (skip_epi && pk.x != 0x12345678u) return;
      if (n < DIN) {
        if (n >= N_NK && n < N_NG) {
          if (n < N_NV) {
            int hd = n - N_NK, h = hd >> 6, d = hd & 63;
            if (m < NX) { int b = m >> 11, t = m & 2047; *(uint4*)(natkx + (((size_t)(b * 6 + h)) * 2048 + t) * 64 + d) = pk; }
            else { int mc = m - NX, b = mc >> 8, t = mc & 255; *(uint4*)(natkc + (((size_t)(b * 6 + h)) * 256 + t) * 64 + d) = pk; }
          } else {
            int hd = n - N_NV, h = hd >> 6, d = hd & 63;
            u16* dst;
            if (m < NX) { int b = m >> 11, t = m & 2047; dst = natvx + ((((size_t)(b * 6 + h)) * 256 + (t >> 3)) * 64 + d) * 8 + (t & 7); }
            else { int mc = m - NX, b = mc >> 8, t = mc & 255; dst = natvc + ((((size_t)(b * 6 + h)) * 32 + (t >> 3)) * 64 + d) * 8 + (t & 7); }
            dst[0] = (u16)(pk.x & 0xffffu); dst[8] = (u16)(pk.x >> 16); dst[16] = (u16)(pk.y & 0xffffu); dst[24] = (u16)(pk.y >> 16);
            dst[32] = (u16)(pk.z & 0xffffu); dst[40] = (u16)(pk.z >> 16); dst[48] = (u16)(pk.w & 0xffffu); dst[56] = (u16)(pk.w >> 16);
          }
        } else {
          *(uint4*)(proj + (size_t)m * PSTR + (n < N_NK ? n : n - 768)) = pk;
        }
      }
    });
  }
}

struct NaFrag { bf16x8 ka0, ka1, kb0, kb1, v0, v1, v2, v3; };
template <bool LOCAL>
__device__ __forceinline__ void na_load(int kp, const u16* __restrict__ kbase, const u16* __restrict__ vbase, NaFrag& f) {
  const u16* kp0 = kbase + (size_t)(kp * (LOCAL ? 64 : 32)) * 64;
  f.ka0 = *(const bf16x8*)(kp0);
  f.ka1 = *(const bf16x8*)(kp0 + 32);
  f.kb0 = *(const bf16x8*)(kp0 + 4 * 64);
  f.kb1 = *(const bf16x8*)(kp0 + 4 * 64 + 32);
  const u16* vp = vbase + (size_t)(kp * (LOCAL ? 8 : 4)) * 512;
  f.v0 = *(const bf16x8*)(vp);
  f.v1 = *(const bf16x8*)(vp + 128);
  f.v2 = *(const bf16x8*)(vp + 256);
  f.v3 = *(const bf16x8*)(vp + 384);
}
template <bool LOCAL>
__device__ __forceinline__ void na_step(const NaFrag& f, const bf16x8 qf0, const bf16x8 qf1, const float* bp, const int (&bidx)[8],
                                        float& mrun, float& lrun, f32x4 (&o)[4]) {
  constexpr float SC = 0.125f * 1.4426950408889634f;
  {
    const bf16x8 ka0 = f.ka0, ka1 = f.ka1, kb0 = f.kb0, kb1 = f.kb1;
    f32x4 s0 = f32x4{0.f, 0.f, 0.f, 0.f}, s1 = f32x4{0.f, 0.f, 0.f, 0.f};
    s0 = __builtin_amdgcn_mfma_f32_16x16x32_bf16(ka0, qf0, s0, 0, 0, 0);
    s1 = __builtin_amdgcn_mfma_f32_16x16x32_bf16(kb0, qf0, s1, 0, 0, 0);
    s0 = __builtin_amdgcn_mfma_f32_16x16x32_bf16(ka1, qf1, s0, 0, 0, 0);
    s1 = __builtin_amdgcn_mfma_f32_16x16x32_bf16(kb1, qf1, s1, 0, 0, 0);
    float mx;
    if (LOCAL) {
#pragma unroll
      for (int e = 0; e < 4; ++e) { s0[e] = fmaf(s0[e], SC, bp[bidx[e]]); s1[e] = fmaf(s1[e], SC, bp[bidx[4 + e]]); }
    } else {
#pragma unroll
      for (int e = 0; e < 4; ++e) { s0[e] *= SC; s1[e] *= SC; }
    }
    mx = fmaxf(fmaxf(fmaxf(s0[0], s0[1]), fmaxf(s0[2], s0[3])), fmaxf(fmaxf(s1[0], s1[1]), fmaxf(s1[2], s1[3])));
    mx = fmaxf(mx, __shfl_xor(mx, 16));
    mx = fmaxf(mx, __shfl_xor(mx, 32));
    const bool grow = __any(mx > mrun + 8.f);
    float mnew = mrun;
    if (grow) {
      mnew = fmaxf(mrun, mx);
      const float alpha = __builtin_amdgcn_exp2f(mrun - mnew);
      lrun *= alpha;
#pragma unroll
      for (int dt = 0; dt < 4; ++dt) o[dt] = o[dt] * alpha;
    }
    float sum = 0.f;
#pragma unroll
    for (int e = 0; e < 4; ++e) {
      float p0 = __builtin_amdgcn_exp2f(s0[e] - mnew), p1 = __builtin_amdgcn_exp2f(s1[e] - mnew);
      s0[e] = p0; s1[e] = p1;
      sum += p0 + p1;
    }
    lrun += sum;
    mrun = mnew;
    u32x4 pu;
    pu[0] = pack2(s0[0], s0[1]);
    pu[1] = pack2(s0[2], s0[3]);
    pu[2] = pack2(s1[0], s1[1]);
    pu[3] = pack2(s1[2], s1[3]);
    const bf16x8 pfv = __builtin_bit_cast(bf16x8, pu);
    o[0] = __builtin_amdgcn_mfma_f32_16x16x32_bf16(f.v0, pfv, o[0], 0, 0, 0);
    o[1] = __builtin_amdgcn_mfma_f32_16x16x32_bf16(f.v1, pfv, o[1], 0, 0, 0);
    o[2] = __builtin_amdgcn_mfma_f32_16x16x32_bf16(f.v2, pfv, o[2], 0, 0, 0);
    o[3] = __builtin_amdgcn_mfma_f32_16x16x32_bf16(f.v3, pfv, o[3], 0, 0, 0);
  }
}

__device__ __forceinline__ int na_kswz(int key) { return (((key >> 3) & 3) << 1) | ((key >> 1) & 1); }
template <bool LAT>
__device__ __forceinline__ void na_unit(const Params& P, int l, int unit, float* sm) {
  const int tid = get_tid(), lane = tid & 63, w = __builtin_amdgcn_readfirstlane(tid >> 6);
  const int qi = lane & 15, g = lane >> 4;
  int b, h, r = 0, c0 = 0, m;
  float* srpb = sm;
  u16* ring = (u16*)(sm + 512);
  constexpr int KL = 0, VL = 4096, KC = LAT ? 8192 : 0, VC = LAT ? 10240 : 2048, SLOT = LAT ? 12288 : 4096;
  constexpr int NI = LAT ? 6 : 2;
  __syncthreads();
  if (LAT) {
    r = unit & 31; h = (unit >> 5) % 6; b = unit / 192;
    c0 = 16 * w;
    m = b * 2048 + r * 64 + c0 + qi;
    for (int i = tid; i < 15 * 32; i += NTHREADS) { int rw = i >> 5, cc = i & 31; srpb[i] = (cc < 31) ? P.rpb[((size_t)l * 6 + h) * 465 + rw * 31 + cc] * 1.4426950408889634f : -1e30f; }
  } else {
    int qt = unit & 3; h = (unit >> 2) % 6; b = unit / 24;
    m = NX + b * 256 + (qt * 4 + w) * 16 + qi;
  }
  const u16* proj = P.proj;
  const bf16x8 qf0 = *(const bf16x8*)(proj + (size_t)m * PSTR + C_NQ + h * 64 + g * 8);
  const bf16x8 qf1 = *(const bf16x8*)(proj + (size_t)m * PSTR + C_NQ + h * 64 + 32 + g * 8);
  const int rs = LAT ? min(max(r - 4, 0), 24) : 0;
  const int ws = LAT ? min(max(c0 - 8, 0), 32) : 0;
  const int qc = c0 + qi;
  const int cs = min(max(qc - 8, 0), 48);
  const int dkey = lane >> 3, dslot = lane & 7;
  const size_t bh = (size_t)(b * 6 + h);
  const u16* gKL0 = P.natkx + (bh * 2048 + rs * 64 + w * 8 + dkey) * 64 + ((dslot ^ na_kswz(w * 8 + dkey)) * 8);
  const u16* gKL1 = P.natkx + (bh * 2048 + rs * 64 + 32 + w * 8 + dkey) * 64 + ((dslot ^ na_kswz(32 + w * 8 + dkey)) * 8);
  const u16* gVL0 = P.natvx + (bh * 256 + rs * 8) * 512 + w * 512 + lane * 8;
  const u16* gVL1 = gVL0 + 4 * 512;
  const u16* gKC = P.natkc + (bh * 256 + w * 8 + dkey) * 64 + ((dslot ^ na_kswz(w * 8 + dkey)) * 8);
  const u16* gVC = P.natvc + (bh * 32) * 512 + w * 512 + lane * 8;
  const int lseg = w * 512 + lane * 8;
#define GLDS(gp, lp) __builtin_amdgcn_global_load_lds((const unsigned*)(gp), (unsigned*)(lp), 16, 0, 0)
  const u16 *pKL0 = gKL0, *pKL1 = gKL1, *pVL0 = gVL0, *pVL1 = gVL1, *pKC = gKC, *pVC = gVC;
#define NA_ISSUE(slot) { u16* _s = ring + (slot) * SLOT; \
    if (LAT) { GLDS(pKL0, _s + KL + lseg); GLDS(pKL1, _s + KL + 2048 + lseg); GLDS(pVL0, _s + VL + lseg); GLDS(pVL1, _s + VL + 2048 + lseg); \
               pKL0 += 64 * 64; pKL1 += 64 * 64; pVL0 += 8 * 512; pVL1 += 8 * 512; } \
    GLDS(pKC, _s + KC + lseg); GLDS(pVC, _s + VC + lseg); pKC += 32 * 64; pVC += 4 * 512; }
#define RAW_BARRIER() do { asm volatile("s_waitcnt lgkmcnt(0)" ::: "memory"); __builtin_amdgcn_s_barrier(); asm volatile("" ::: "memory"); } while (0)
  const int prow = (qi >> 2) * 8 + (qi & 3);
  const int fL = na_kswz(ws + prow), fC = na_kswz(prow);
  const int rKL = KL + (ws + prow) * 64, rKC = KC + prow * 64;
  const int cL0 = ((g) ^ fL) * 8, cL1 = ((4 + g) ^ fL) * 8, cC0 = ((g) ^ fC) * 8, cC1 = ((4 + g) ^ fC) * 8;
  const int rVL = VL + (((ws >> 3) + g) * 64 + qi) * 8, rVC = VC + (g * 64 + qi) * 8;
  int bidx[8];
#pragma unroll
  for (int j = 0; j < 8; ++j) {
    int kc = ws + g * 8 + j;
    bool ok = (kc >= cs) && (kc < cs + 16);
    bidx[j] = ok ? min(max(kc - qc + 15, 0), 30) : 31;
  }
  float mL = -1e30f, lL = 0.f, mC = -1e30f, lC = 0.f;
  f32x4 oL[4], o[4];
#pragma unroll
  for (int dt = 0; dt < 4; ++dt) { oL[dt] = f32x4{0.f, 0.f, 0.f, 0.f}; o[dt] = f32x4{0.f, 0.f, 0.f, 0.f}; }
  asm volatile("s_waitcnt vmcnt(0)" ::: "memory");
  NA_ISSUE(0); NA_ISSUE(1); NA_ISSUE(2);
  int slot = 0;
#pragma unroll 1
  for (int kp = 0; kp < 8; ++kp) {
    if (kp <= 5) { if (LAT) asm volatile("s_waitcnt vmcnt(12)" ::: "memory"); else asm volatile("s_waitcnt vmcnt(4)" ::: "memory"); }
    else if (kp == 6) { if (LAT) asm volatile("s_waitcnt vmcnt(6)" ::: "memory"); else asm volatile("s_waitcnt vmcnt(2)" ::: "memory"); }
    else asm volatile("s_waitcnt vmcnt(0)" ::: "memory");
    RAW_BARRIER();
    __builtin_amdgcn_sched_barrier(0);
    const u16* sl = ring + slot * SLOT;
    NaFrag FL, FC;
    if (LAT) {
      FL.ka0 = *(const bf16x8*)(sl + rKL + cL0); FL.ka1 = *(const bf16x8*)(sl + rKL + cL1);
      FL.kb0 = *(const bf16x8*)(sl + rKL + 4 * 64 + cL0); FL.kb1 = *(const bf16x8*)(sl + rKL + 4 * 64 + cL1);
      FL.v0 = *(const bf16x8*)(sl + rVL); FL.v1 = *(const bf16x8*)(sl + rVL + 128); FL.v2 = *(const bf16x8*)(sl + rVL + 256); FL.v3 = *(const bf16x8*)(sl + rVL + 384);
    }
    FC.ka0 = *(const bf16x8*)(sl + rKC + cC0); FC.ka1 = *(const bf16x8*)(sl + rKC + cC1);
    FC.kb0 = *(const bf16x8*)(sl + rKC + 4 * 64 + cC0); FC.kb1 = *(const bf16x8*)(sl + rKC + 4 * 64 + cC1);
    FC.v0 = *(const bf16x8*)(sl + rVC); FC.v1 = *(const bf16x8*)(sl + rVC + 128); FC.v2 = *(const bf16x8*)(sl + rVC + 256); FC.v3 = *(const bf16x8*)(sl + rVC + 384);
    __builtin_amdgcn_sched_barrier(0);
    RAW_BARRIER();
    __builtin_amdgcn_sched_barrier(0);
    if (kp + 3 < 8) NA_ISSUE(slot);
    slot = (slot == 2) ? 0 : slot + 1;
    __builtin_amdgcn_sched_barrier(0);
    if (LAT) na_step<true>(FL, qf0, qf1, srpb + (rs + kp - r + 7) * 32, bidx, mL, lL, oL);
    na_step<false>(FC, qf0, qf1, srpb, bidx, mC, lC, o);
  }
#undef GLDS
#undef NA_ISSUE
#undef RAW_BARRIER
  lC += __shfl_xor(lC, 16); lC += __shfl_xor(lC, 32);
  if (LAT) { lL += __shfl_xor(lL, 16); lL += __shfl_xor(lL, 32); }
  float lrun = lC;
  if (LAT) {
    const float mm = fmaxf(mL, mC);
    const float aL = __builtin_amdgcn_exp2f(mL - mm), aC = __builtin_amdgcn_exp2f(mC - mm);
    lrun = lL * aL + lC * aC;
#pragma unroll
    for (int dt = 0; dt < 4; ++dt) o[dt] = oL[dt] * aL + o[dt] * aC;
  }
  const float rinv = 1.f / lrun;
#pragma unroll
  for (int dt = 0; dt < 4; ++dt) {
    int d = h * 64 + dt * 16 + g * 4;
    uint2 gg = *(const uint2*)(proj + (size_t)m * PSTR + C_NG + d);
    float g0 = bf2f((u16)(gg.x & 0xffff)), g1 = bf2f((u16)(gg.x >> 16)), g2 = bf2f((u16)(gg.y & 0xffff)), g3 = bf2f((u16)(gg.y >> 16));
    float o0 = o[dt][0] * rinv * silu(g0), o1 = o[dt][1] * rinv * silu(g1), o2 = o[dt][2] * rinv * silu(g2), o3 = o[dt][3] * rinv * silu(g3);
    *(uint2*)(P.hx + (size_t)m * 1024 + 256 + d) = make_uint2(pack2(o0, o1), pack2(o2, o3));
  }
}

__device__ __forceinline__ int gla_tok_row(int b, int c, int tk) {
  return (c < 4) ? (NX + b * 256 + c * 64 + tk) : (b * 2048 + (c - 4) * 64 + tk);
}
__device__ __forceinline__ void unpack8(const uint4 v, float* f) {
  f[0] = __uint_as_float(v.x << 16); f[1] = __uint_as_float(v.x & 0xffff0000u);
  f[2] = __uint_as_float(v.y << 16); f[3] = __uint_as_float(v.y & 0xffff0000u);
  f[4] = __uint_as_float(v.z << 16); f[5] = __uint_as_float(v.z & 0xffff0000u);
  f[6] = __uint_as_float(v.w << 16); f[7] = __uint_as_float(v.w & 0xffff0000u);
}
__device__ __forceinline__ void load24(const u16* p, float* f) {
  uint4 a = *(const uint4*)(p), b = *(const uint4*)(p + 8), c = *(const uint4*)(p + 16);
  unpack8(a, f); unpack8(b, f + 8); unpack8(c, f + 16);
}
template <int MODE>
__device__ __forceinline__ void gla_prep(const Params& P, int l, int b, int h, int c, int dir, u16* s0, u16* s1, float* decp, float* gla_stage, float* bstore) {
  const int tid = get_tid(), lane = tid & 63, w = __builtin_amdgcn_readfirstlane(tid >> 6);
  const bool lat = c >= 4;
  const int row = gla_tok_row(b, c, lane);
  const u16* prow = P.proj + (size_t)row * PSTR;
  const int half = w >> 1, hi = w & 1;
  float cs[24];
  if (lat) {
    const float* cp = P.ropecs + ((size_t)(row & 2047) * 24 + half * 12) * 2;
#pragma unroll
    for (int q = 0; q < 6; ++q) {
      float4 v = *(const float4*)(cp + 4 * q);
      cs[4 * q] = v.x; cs[4 * q + 1] = v.y; cs[4 * q + 2] = v.z; cs[4 * q + 3] = v.w;
    }
  } else {
#pragma unroll
    for (int q = 0; q < 12; ++q) { cs[2 * q] = 1.f; cs[2 * q + 1] = 0.f; }
  }
  uint4 kraw0 = *(const uint4*)(prow + C_GK + h * 48 + half * 24), kraw1 = *(const uint4*)(prow + C_GK + h * 48 + half * 24 + 8), kraw2 = *(const uint4*)(prow + C_GK + h * 48 + half * 24 + 16);
  uint4 qraw0 = kraw0, qraw1 = kraw1, qraw2 = kraw2;
  if (MODE == 1) { qraw0 = *(const uint4*)(prow + C_GQ + h * 48 + half * 24); qraw1 = *(const uint4*)(prow + C_GQ + h * 48 + half * 24 + 8); qraw2 = *(const uint4*)(prow + C_GQ + h * 48 + half * 24 + 16); }
  float bb[12];
  float* const bmine = bstore + lane * 48 + 12 * w;
  if (MODE == 0) {
  const float* wag = (dir ? P.wab : P.waf) + (size_t)l * 16 * 192 + h * 48;
  const float* ba = (dir ? P.bab : P.baf) + (size_t)l * 192 + h * 48 + 12 * w;
  float* swa = gla_stage;
  float* sz = gla_stage + 768;
  __syncthreads();
  for (int i = tid; i < 768; i += NTHREADS) { int rr = i / 48, kk = i % 48; swa[i] = wag[rr * 192 + kk]; }
  {
    int tk = tid >> 2, q = tid & 3;
    uint2 zz = *(const uint2*)(P.proj + (size_t)gla_tok_row(b, c, tk) * PSTR + C_ZF + dir * 16 + q * 4);
    float* d = sz + tk * 17 + q * 4;
    d[0] = __uint_as_float(zz.x << 16); d[1] = __uint_as_float(zz.x & 0xffff0000u);
    d[2] = __uint_as_float(zz.y << 16); d[3] = __uint_as_float(zz.y & 0xffff0000u);
  }
  __syncthreads();
#pragma unroll
  for (int j = 0; j < 12; ++j) bb[j] = ba[j];
#pragma unroll 1
  for (int rr = 0; rr < 16; ++rr) {
    const float zv = sz[lane * 17 + rr];
    const float4 w0 = *(const float4*)(swa + rr * 48 + 12 * w);
    const float4 w1 = *(const float4*)(swa + rr * 48 + 12 * w + 4);
    const float4 w2 = *(const float4*)(swa + rr * 48 + 12 * w + 8);
    bb[0] += zv * w0.x; bb[1] += zv * w0.y; bb[2] += zv * w0.z; bb[3] += zv * w0.w;
    bb[4] += zv * w1.x; bb[5] += zv * w1.y; bb[6] += zv * w1.z; bb[7] += zv * w1.w;
    bb[8] += zv * w2.x; bb[9] += zv * w2.y; bb[10] += zv * w2.z; bb[11] += zv * w2.w;
  }
#pragma unroll
  for (int j = 0; j < 12; ++j) {
    float gsum = bb[j];
    float ls = fminf(gsum, 0.f) - __logf(1.f + __expf(-fabsf(gsum)));
    bb[j] = ls * (1.f / 16.f);
  }
#pragma unroll
  for (int off = 1; off < 64; off <<= 1) {
#pragma unroll
    for (int j = 0; j < 12; ++j) {
      float t = dir ? __shfl_down(bb[j], off) : __shfl_up(bb[j], off);
      bool ok = dir ? (lane + off < 64) : (lane >= off);
      bb[j] += ok ? t : 0.f;
    }
  }
  *(float4*)(bmine) = make_float4(bb[0], bb[1], bb[2], bb[3]);
  *(float4*)(bmine + 4) = make_float4(bb[4], bb[5], bb[6], bb[7]);
  *(float4*)(bmine + 8) = make_float4(bb[8], bb[9], bb[10], bb[11]);
  } else {
    const float4 b0 = *(const float4*)(bmine), b1 = *(const float4*)(bmine + 4), b2 = *(const float4*)(bmine + 8);
    bb[0] = b0.x; bb[1] = b0.y; bb[2] = b0.z; bb[3] = b0.w; bb[4] = b1.x; bb[5] = b1.y; bb[6] = b1.z; bb[7] = b1.w;
    bb[8] = b2.x; bb[9] = b2.y; bb[10] = b2.z; bb[11] = b2.w;
  }
  float kr[24];
  unpack8(kraw0, kr); unpack8(kraw1, kr + 8); unpack8(kraw2, kr + 16);
  if (MODE == 0) {
    unsigned pk[6];
    float bend[12];
#pragma unroll
    for (int j = 0; j < 12; ++j) bend[j] = __shfl(bb[j], dir ? 0 : 63);
#pragma unroll
    for (int j = 0; j < 12; ++j) {
      float c0 = cs[2 * j], s0v = cs[2 * j + 1];
      float rot = hi ? (kr[j] * s0v + kr[12 + j] * c0) : (kr[j] * c0 - kr[12 + j] * s0v);
      float val = rot * __expf(bend[j] - bb[j]);
      s0[(12 * w + j) * 72 + lane] = f2bf(val);
    }
    if (lane == 0) {
#pragma unroll
      for (int j = 0; j < 12; ++j) decp[12 * w + j] = __expf(bend[j]);
    }
    (void)pk;
  } else {
    float qr[24];
    unpack8(qraw0, qr); unpack8(qraw1, qr + 8); unpack8(qraw2, qr + 16);
    unsigned pq[6], pkk[6];
#pragma unroll
    for (int j2 = 0; j2 < 6; ++j2) {
      float vq[2], vk[2];
#pragma unroll
      for (int e = 0; e < 2; ++e) {
        int j = 2 * j2 + e;
        float c0 = cs[2 * j], s0v = cs[2 * j + 1];
        float rq = hi ? (qr[j] * s0v + qr[12 + j] * c0) : (qr[j] * c0 - qr[12 + j] * s0v);
        float rk = hi ? (kr[j] * s0v + kr[12 + j] * c0) : (kr[j] * c0 - kr[12 + j] * s0v);
        float eb = __expf(bb[j]);
        vq[e] = rq * 0.14433756729740643f * eb;
        vk[e] = rk / eb;
      }
      pq[j2] = pack2(vq[0], vq[1]);
      pkk[j2] = pack2(vk[0], vk[1]);
    }
    u16* dq = s0 + lane * 72 + 12 * w;
    u16* dk = s1 + lane * 72 + 12 * w;
    *(uint2*)(dq) = make_uint2(pq[0], pq[1]); *(uint2*)(dq + 4) = make_uint2(pq[2], pq[3]); *(uint2*)(dq + 8) = make_uint2(pq[4], pq[5]);
    *(uint2*)(dk) = make_uint2(pkk[0], pkk[1]); *(uint2*)(dk + 4) = make_uint2(pkk[2], pkk[3]); *(uint2*)(dk + 8) = make_uint2(pkk[4], pkk[5]);
  }
}
__device__ __forceinline__ void gla_load_vT(const Params& P, int b, int h, int c, u16* svT) {
  const int tid = get_tid(), lane = tid & 63, w = __builtin_amdgcn_readfirstlane(tid >> 6);
  const u16* p = P.proj + (size_t)gla_tok_row(b, c, lane) * PSTR + C_GV + h * 96 + 24 * w;
  uint4 a = *(const uint4*)(p), bq = *(const uint4*)(p + 8), cq = *(const uint4*)(p + 16);
  unsigned wv[12] = {a.x, a.y, a.z, a.w, bq.x, bq.y, bq.z, bq.w, cq.x, cq.y, cq.z, cq.w};
#pragma unroll
  for (int q = 0; q < 12; ++q) {
    svT[(24 * w + 2 * q) * 72 + lane] = (u16)(wv[q] & 0xffffu);
    svT[(24 * w + 2 * q + 1) * 72 + lane] = (u16)(wv[q] >> 16);
  }
}

__device__ void gla_g1_unit(const Params& P, int l, int unit, float* sm) {
  const int tid = get_tid(), lane = tid & 63, w = __builtin_amdgcn_readfirstlane(tid >> 6), g = lane >> 4, li = lane & 15;
  int chain = unit / NCH, n = unit % NCH;
  int b = chain >> 3, h = (chain >> 1) & 3, dir = chain & 1;
  int c = (dir == 0) ? n : (n < 4 ? 3 - n : 39 - n);
  u16* svT = (u16*)sm;
  u16* skT = svT + 96 * 72;
  __syncthreads();
  gla_load_vT(P, b, h, c, svT);
  gla_prep<0>(P, l, b, h, c, dir, skT, nullptr, P.dec + (size_t)unit * 48, sm + 8192, P.gb + (size_t)unit * 3072);
  __syncthreads();
  u16* kvp = P.kv + (size_t)unit * 4608;
  for (int vt = w; vt < 6; vt += 4) {
    f32x4 acc[3];
#pragma unroll
    for (int j = 0; j < 3; ++j) acc[j] = f32x4{0.f, 0.f, 0.f, 0.f};
#pragma unroll
    for (int ks = 0; ks < 2; ++ks) {
      bf16x8 af = *(const bf16x8*)(svT + (vt * 16 + li) * 72 + ks * 32 + g * 8);
#pragma unroll
      for (int j = 0; j < 3; ++j) {
        bf16x8 bfv = *(const bf16x8*)(skT + (j * 16 + li) * 72 + ks * 32 + g * 8);
        acc[j] = __builtin_amdgcn_mfma_f32_16x16x32_bf16(af, bfv, acc[j], 0, 0, 0);
      }
    }
#pragma unroll
    for (int j = 0; j < 3; ++j)
#pragma unroll
      for (int e = 0; e < 4; ++e) kvp[(vt * 16 + g * 4 + e) * 48 + j * 16 + li] = f2bf(acc[j][e]);
  }
}

__device__ void gla_g2(const Params& P, int idx) {
  int chain = idx / 4608, e = idx % 4608, kk = e % 48;
  u16* kp = P.kv + (size_t)chain * NCH * 4608 + e;
  const float* dp = P.dec + (size_t)chain * NCH * 48 + kk;
  float kvv[NCH], dd[NCH];
#pragma unroll
  for (int n = 0; n < NCH; ++n) { kvv[n] = bf2f(kp[(size_t)n * 4608]); dd[n] = dp[n * 48]; }
  float S = 0.f;
#pragma unroll
  for (int n = 0; n < NCH; ++n) {
    kp[(size_t)n * 4608] = f2bf(S);
    S = dd[n] * S + kvv[n];
  }
}

__device__ void gla_g3_unit(const Params& P, int l, int unit, float* sm) {
  const int tid = get_tid(), lane = tid & 63, w = __builtin_amdgcn_readfirstlane(tid >> 6), g = lane >> 4, li = lane & 15;
  int c = unit % NCH, h = (unit / NCH) & 3, b = unit / (NCH * 4);
  u16* svT = (u16*)sm;
  u16* sqd = svT + 96 * 72;
  u16* skd = sqd + 64 * 72;
  __syncthreads();
  gla_load_vT(P, b, h, c, svT);
  for (int i = tid; i < 64 * 8; i += NTHREADS) {
    int r = i >> 3, q = i & 7;
    *(unsigned*)(sqd + r * 72 + 48 + 2 * q) = 0u;
    *(unsigned*)(skd + r * 72 + 48 + 2 * q) = 0u;
  }
  f32x4 o[6];
#pragma unroll
  for (int vt = 0; vt < 6; ++vt) o[vt] = f32x4{0.f, 0.f, 0.f, 0.f};
  const int tkq = 16 * w + li;
#pragma unroll 1
  for (int dir = 0; dir < 2; ++dir) {
    const int chain = (b * 4 + h) * 2 + dir;
    const int n = (dir == 0) ? c : (c < 4 ? 3 - c : 39 - c);
    const u16* Sp = P.kv + ((size_t)chain * NCH + n) * 4608;
    bf16x8 sfa[6], sfb[6];
#pragma unroll
    for (int vt = 0; vt < 6; ++vt) {
      const u16* sp = Sp + (vt * 16 + li) * 48 + g * 8;
      sfa[vt] = *(const bf16x8*)(sp);
      u32x4 zz = u32x4{0u, 0u, 0u, 0u};
      sfb[vt] = __builtin_bit_cast(bf16x8, zz);
      if (g < 2) sfb[vt] = *(const bf16x8*)(sp + 32);
    }
    gla_prep<1>(P, l, b, h, c, dir, sqd, skd, nullptr, sm + 8192, P.gb + ((size_t)chain * NCH + n) * 3072);
    __syncthreads();
    const bf16x8 q0 = *(const bf16x8*)(sqd + tkq * 72 + g * 8);
    const bf16x8 q1 = *(const bf16x8*)(sqd + tkq * 72 + 32 + g * 8);
    f32x4 st[4];
#pragma unroll
    for (int t = 0; t < 4; ++t) {
      f32x4 a = f32x4{0.f, 0.f, 0.f, 0.f};
      const bool need = dir ? (t >= w) : (t <= w);
      if (need) {
        bf16x8 k0 = *(const bf16x8*)(skd + (t * 16 + li) * 72 + g * 8);
        bf16x8 k1 = *(const bf16x8*)(skd + (t * 16 + li) * 72 + 32 + g * 8);
        a = __builtin_amdgcn_mfma_f32_16x16x32_bf16(k0, q0, a, 0, 0, 0);
        a = __builtin_amdgcn_mfma_f32_16x16x32_bf16(k1, q1, a, 0, 0, 0);
#pragma unroll
        for (int e = 0; e < 4; ++e) {
          int sidx = t * 16 + g * 4 + e;
          bool valid = dir ? (sidx >= tkq) : (sidx <= tkq);
          a[e] = valid ? a[e] : 0.f;
        }
      }
      st[t] = a;
    }
#pragma unroll
    for (int pr = 0; pr < 2; ++pr) {
      u32x4 pu;
      pu[0] = pack2(st[2 * pr][0], st[2 * pr][1]);
      pu[1] = pack2(st[2 * pr][2], st[2 * pr][3]);
      pu[2] = pack2(st[2 * pr + 1][0], st[2 * pr + 1][1]);
      pu[3] = pack2(st[2 * pr + 1][2], st[2 * pr + 1][3]);
      const bf16x8 pfv = __builtin_bit_cast(bf16x8, pu);
#pragma unroll
      for (int vt = 0; vt < 6; ++vt) {
        const u16* vp = svT + (vt * 16 + li) * 72 + pr * 32 + g * 4;
        uint2 va = *(const uint2*)(vp);
        uint2 vb = *(const uint2*)(vp + 16);
        u32x4 vu; vu[0] = va.x; vu[1] = va.y; vu[2] = vb.x; vu[3] = vb.y;
        o[vt] = __builtin_amdgcn_mfma_f32_16x16x32_bf16(__builtin_bit_cast(bf16x8, vu), pfv, o[vt], 0, 0, 0);
      }
    }
#pragma unroll
    for (int vt = 0; vt < 6; ++vt) {
      o[vt] = __builtin_amdgcn_mfma_f32_16x16x32_bf16(sfa[vt], q0, o[vt], 0, 0, 0);
      o[vt] = __builtin_amdgcn_mfma_f32_16x16x32_bf16(sfb[vt], q1, o[vt], 0, 0, 0);
    }
    __syncthreads();
  }
  float ss = 0.f;
#pragma unroll
  for (int vt = 0; vt < 6; ++vt)
#pragma unroll
    for (int e = 0; e < 4; ++e) ss += o[vt][e] * o[vt][e];
  ss += __shfl_xor(ss, 16);
  ss += __shfl_xor(ss, 32);
  const float rstd = rsqrtf(ss * (1.f / 96.f) + 1e-6f);
  const int row = gla_tok_row(b, c, tkq);
  const float* gw = P.gnw + l * 96;
#pragma unroll
  for (int vt = 0; vt < 6; ++vt) {
    int vv = vt * 16 + g * 4;
    uint2 gg = *(const uint2*)(P.proj + (size_t)row * PSTR + C_GG + h * 96 + vv);
    float4 gwv = *(const float4*)(gw + vv);
    float g0 = bf2f((u16)(gg.x & 0xffff)), g1 = bf2f((u16)(gg.x >> 16)), g2 = bf2f((u16)(gg.y & 0xffff)), g3 = bf2f((u16)(gg.y >> 16));
    float o0 = o[vt][0] * rstd * gwv.x * silu(g0), o1 = o[vt][1] * rstd * gwv.y * silu(g1);
    float o2 = o[vt][2] * rstd * gwv.z * silu(g2), o3 = o[vt][3] * rstd * gwv.w * silu(g3);
    *(uint2*)(P.hx + (size_t)row * 1024 + 640 + h * 96 + vv) = make_uint2(pack2(o0, o1), pack2(o2, o3));
  }
}

constexpr int P4_NFX = NB * 16 * 2;
constexpr int NA_PER_IDLE = 2;
__device__ __forceinline__ int na_total(bool last) { return NB * 32 * 6 + (last ? 0 : NB * 6 * 4); }
__device__ __forceinline__ int p4_nfc(bool last) { return last ? 0 : NB * 2 * 2; }
__device__ __forceinline__ int na_p4_count(int nb, bool last) {
  const int n_idle = nb > P4_NFX ? nb - P4_NFX : 0, nfc = p4_nfc(last);
  const int a = n_idle < nfc ? n_idle : nfc;
  int c = (NA_PER_IDLE - 1) * a + NA_PER_IDLE * (n_idle - a);
  const int tot = na_total(last);
  return c < tot ? c : tot;
}
__device__ __forceinline__ void na_any(const Params& P, int l, int id, float* sm) {
  const int n_na = NB * 32 * 6;
  if (id < n_na) na_unit<true>(P, l, id, sm); else na_unit<false>(P, l, id - n_na, sm);
}

__device__ void phase3(const Params& P, int l, int bid, int nb, float* sm, int mask) {
  const bool last = (l == DEPTH - 1);
  const int n_cut = na_total(last) - na_p4_count(nb, last);
  const int n_g1 = NUNIT_G;
  const int n_f1 = (last ? (NX + 191) / 192 : NT / 192) * 4;
  const int total = n_cut + n_g1 + n_f1;
  for (int u = bid; u < total; u += nb) {
    int v = u;
    if (v < n_cut) { if (mask & 1) na_any(P, l, v, sm); continue; }
    v -= n_cut;
    if (v < n_g1) { if (mask & 2) gla_g1_unit(P, l, v, sm); continue; }
    v -= n_g1;
    if (mask & 4) {
      int mt = v >> 2, gq = v & 3;
      u16* const vtx = P.vtx; u16* const vtc = P.vtc;
      gemm_tile<192, 0>(P.proj + C_FIN + gq * 64, PSTR, P.dft64, 64, 64, mt * 192, 0, (u16*)sm, [=](int m, int n, f32x4 val) {
        int part = n >> 6, j = n & 63;
        if (m < NX) {
          int b = m >> 11, t = m & 2047;
          u16* d = vtx + ((size_t)(b * 256 + gq * 64 + j)) * 4096 + part * 2048 + t;
#pragma unroll
          for (int q = 0; q < 4; ++q) d[(size_t)q * 4096] = f2bf(val[q]);
        } else {
          int mc = m - NX, b = mc >> 8, t = mc & 255;
          u16* d = vtc + ((size_t)(b * 256 + gq * 64 + j)) * 512 + part * 256 + t;
#pragma unroll
          for (int q = 0; q < 4; ++q) d[(size_t)q * 512] = f2bf(val[q]);
        }
      });
    }
  }
}

__device__ void phase4(const Params& P, int l, int bid, int nb, float* sm, int noscan) {
  const bool last = (l == DEPTH - 1);
  const int n_fx = P4_NFX;
  const int n_fc = p4_nfc(last);
  const int n_sc = (64 * 4608) / NTHREADS;
  const int n_idle = nb > n_fx ? nb - n_fx : 0;
  u16* const proj = P.proj;
  for (int v = bid; v < n_fx; v += nb) {
    int b = v >> 5, mt = (v >> 1) & 15, nt = v & 1;
    gemm_tile<128, 0>(P.dftL, 4096, P.vtx + (size_t)b * 256 * 4096, 4096, 4096, mt * 128, nt * 128, (u16*)sm, [=](int m, int n, f32x4 val) {
      *(uint2*)(proj + (size_t)(b * 2048 + m) * PSTR + C_FIN + n) = make_uint2(pack2(val[0], val[1]), pack2(val[2], val[3]));
    });
  }
  {
    const int j = bid - n_fx;
    const int jj = (n_idle > 0) ? j : bid, jstride = (n_idle > 0) ? n_idle : nb;
    if (n_idle == 0 || j >= 0) {
      for (int v = jj; v < n_fc; v += jstride) {
        int b = v >> 2, mt = (v >> 1) & 1, nt = v & 1;
        gemm_tile<128, 0>(P.dftC, 512, P.vtc + (size_t)b * 256 * 512, 512, 512, mt * 128, nt * 128, (u16*)sm, [=](int m, int n, f32x4 val) {
          *(uint2*)(proj + (size_t)(NX + b * 256 + m) * PSTR + C_FIN + n) = make_uint2(pack2(val[0], val[1]), pack2(val[2], val[3]));
        });
      }
    }
    if (!noscan && j >= 0) {
      const int tot = na_total(last), cut = tot - na_p4_count(nb, last);
      const int a = n_idle < n_fc ? n_idle : n_fc;
      const int nmine = (j < a) ? NA_PER_IDLE - 1 : NA_PER_IDLE;
      const int base = cut + ((j < a) ? (NA_PER_IDLE - 1) * j : (NA_PER_IDLE - 1) * a + NA_PER_IDLE * (j - a));
      for (int q = 0; q < nmine; ++q) { const int id = base + q; if (id < tot) na_any(P, l, id, sm); }
    }
  }
  if (!noscan) for (int v = bid; v < n_sc; v += nb) gla_g2(P, v * NTHREADS + get_tid());
}

__device__ void phase5(const Params& P, int l, int bid, int nb, float* sm) {
  const bool last = (l == DEPTH - 1);
  const int n_g3 = NB * 4 * NCH;
  const int n_w4 = (last ? (NX + 191) / 192 : NT / 192) * 2;
  const int total = n_g3 + n_w4;
  for (int u = bid; u < total; u += nb) {
    int v = u;
    if (v < n_g3) {
      int c = v % NCH;
      if (last && c < 4) continue;
      gla_g3_unit(P, l, v, sm);
      continue;
    }
    v -= n_g3;
    int mt = v >> 1, nt = v & 1;
    u16* const proj = P.proj; u16* const mix = P.hx;
    gemm_tile<192, 0>(P.proj + C_FIN, PSTR, P.wtfour, 256, 256, mt * 192, nt * 128, (u16*)sm, [=](int m, int n, f32x4 val) {
      if (last && m >= NX) return;
      uint2 gg = *(const uint2*)(proj + (size_t)m * PSTR + C_FG + n);
      float g0 = bf2f((u16)(gg.x & 0xffff)), g1 = bf2f((u16)(gg.x >> 16)), g2 = bf2f((u16)(gg.y & 0xffff)), g3 = bf2f((u16)(gg.y >> 16));
      *(uint2*)(mix + (size_t)m * 1024 + n) = make_uint2(pack2(val[0] * silu(g0), val[1] * silu(g1)), pack2(val[2] * silu(g2), val[3] * silu(g3)));
    });
  }
}

__device__ void phase6(const Params& P, int l, int bid, int nb, float* sm, int skip_epi) {
  const bool last = (l == DEPTH - 1);
  const int nmt = last ? (NX + 191) / 192 : NT / 192;
  const int total = nmt * 8;
  for (int u = bid; u < total; u += nb) {
    int mt = u >> 3, nt = u & 7;
    const float* const modl = P.mod + (size_t)l * 9 * 3072;
    const float* const xs = (l == 0 ? P.x : P.out); const float* const cs = (l == 0 ? P.ctx : P.ctxw);
    float* const xo = P.out; float* const co = P.ctxw;
    gemm_tile<192, 0>(P.hx, 1024, P.wtout, 1024, 1024, mt * 192, nt * 128, (u16*)sm, [=](int m, int n, f32x4 val) {
      if (skip_epi && val[0] != 12345.678f) return;
      if (last && m >= NX) return;
      int s = (m < NX) ? (m >> 11) : 8;
      float4 gt = *(const float4*)(modl + (size_t)s * 3072 + 2048 + n);
      const float* src; float* dst;
      if (m < NX) { src = xs + (size_t)m * 1024 + n; dst = xo + (size_t)m * 1024 + n; }
      else { src = cs + (size_t)(m - NX) * 1024 + n; dst = co + (size_t)(m - NX) * 1024 + n; }
      float4 xv = *(const float4*)src;
      float4 r = make_float4(xv.x + gt.x * val[0], xv.y + gt.y * val[1], xv.z + gt.z * val[2], xv.w + gt.w * val[3]);
      *(float4*)dst = r;
    });
  }
}

__device__ void phasef(const Params& P, int bid, int nb) {
  const int tid = get_tid(), lane = tid & 63, w = tid >> 6;
  for (int row0 = (bid * 4 + w) * 4; row0 < NX; row0 += nb * 16) {
    float* src = P.out + (size_t)row0 * 1024;
    float4 v[4][4];
#pragma unroll
    for (int rr = 0; rr < 4; ++rr)
#pragma unroll
      for (int p = 0; p < 4; ++p) v[rr][p] = *(const float4*)(src + rr * 1024 + (p * 64 + lane) * 4);
    float rstd[4];
#pragma unroll
    for (int rr = 0; rr < 4; ++rr) {
      float ss = 0.f;
#pragma unroll
      for (int p = 0; p < 4; ++p) ss += v[rr][p].x * v[rr][p].x + v[rr][p].y * v[rr][p].y + v[rr][p].z * v[rr][p].z + v[rr][p].w * v[rr][p].w;
      ss = wave_sum(ss);
      rstd[rr] = rsqrtf(ss * (1.f / 1024.f) + 1e-6f);
    }
#pragma unroll
    for (int p = 0; p < 4; ++p) {
      int c0 = (p * 64 + lane) * 4;
      float4 wv = *(const float4*)(P.norm_f + c0);
#pragma unroll
      for (int rr = 0; rr < 4; ++rr)
        *(float4*)(src + rr * 1024 + c0) = make_float4(v[rr][p].x * rstd[rr] * wv.x, v[rr][p].y * rstd[rr] * wv.y, v[rr][p].z * rstd[rr] * wv.z, v[rr][p].w * rstd[rr] * wv.w);
    }
  }
}

__global__ void __launch_bounds__(NTHREADS, 2) mega(Params P, int ph_lo, int ph_hi, int coop) {
  extern __shared__ __attribute__((aligned(16))) unsigned char lds[];
  float* sm = (float*)lds;
  cg::grid_group grid = cg::this_grid();
  const int bid = blockIdx.x, nb = gridDim.x;
  XcdBarrier xb = xcd_barrier_post(P.bar, (unsigned*)lds);
  int vbid = bid;
  for (int ph = ph_lo; ph < ph_hi; ++ph) {
    if (ph == 0) phase0(P, bid, nb, sm);
    else if (ph == 1 + 6 * DEPTH) phasef(P, bid, nb);
    else {
      int l = (ph - 1) / 6, sub = (ph - 1) % 6;
      if (ph == 1) vbid = xcd_vbid(xb);
      for (int rep = 0; rep < ((sub == REP_SUB) ? 2 : 1); ++rep) {
      if (rep) xcd_barrier(xb);
      switch (sub) {
        case 0: phase1(P, l, bid, nb, sm); break;
        case 1: phase2(P, vbid, nb, (u16*)sm, (PROBE_SKIP_EPI && rep) ? 1 : 0); break;
        case 2: phase3(P, l, vbid, nb, sm, rep ? PROBE_MASK : 7); break;
        case 3: phase4(P, l, bid, nb, sm, rep); break;
        case 4: phase5(P, l, bid, nb, sm); break;
        case 5: phase6(P, l, vbid, nb, sm, rep); break;
        default: break;
      }
      }
    }
    if (coop && ph + 1 < ph_hi) { if (coop == 2) grid.sync(); else xcd_barrier(xb); for (int e = 0; e < EXTRA_SYNCS; ++e) xcd_barrier(xb); }
  }
}

extern "C" void kernel_launch(void* const* d_in, const int* in_sizes, int n_in, void* d_out, int out_size, void* d_ws,
                              size_t ws_size, hipStream_t stream) {
  static int grid_blocks = 0;
  if (grid_blocks == 0) {
    int dev = 0, cus = 0, per_cu = 0;
    hipGetDevice(&dev);
    hipDeviceGetAttribute(&cus, hipDeviceAttributeMultiprocessorCount, dev);
    if (hipFuncSetAttribute((const void*)mega, hipFuncAttributeMaxDynamicSharedMemorySize, LDS_BYTES) != hipSuccess) {
      fprintf(stderr, "hipFuncSetAttribute failed\n");
    }
    hipOccupancyMaxActiveBlocksPerMultiprocessor(&per_cu, (const void*)mega, NTHREADS, LDS_BYTES);
    if (per_cu < 1) { fprintf(stderr, "occupancy query returned %d\n", per_cu); per_cu = 1; }
    if (per_cu > 2) per_cu = 2;
    grid_blocks = cus * per_cu;
  }
  Params P{};
  const float* const* in = (const float* const*)d_in;
  P.x = in[0]; P.c = in[1]; P.ctx = in[2]; P.c_ctx = in[3]; P.w_ada = in[4]; P.b_ada = in[5]; P.norm_w = in[6];
  P.w_in = in[7]; P.w_four = in[8]; P.rpb = in[9]; P.waf = in[10]; P.baf = in[11]; P.wab = in[12]; P.bab = in[13];
  P.gnw = in[14]; P.w_out = in[15]; P.norm_f = in[16];
  P.out = (float*)d_out;
  size_t off = 0;
  auto take = [&](size_t bytes) { void* p = (char*)d_ws + off; off += (bytes + 255) & ~(size_t)255; return p; };
  P.mod = (float*)take((size_t)4 * 9 * 3072 * 4);
  P.ropecs = (float*)take((size_t)2048 * 24 * 2 * 4);
  P.dft64 = (u16*)take((size_t)128 * 64 * 2);
  P.dftC = (u16*)take((size_t)256 * 512 * 2);
  P.dftL = (u16*)take((size_t)2048 * 4096 * 2);
  P.wtin = (u16*)take((size_t)DINP * 1024 * 2);
  P.wtout = (u16*)take((size_t)1024 * 1024 * 2);
  P.wtfour = (u16*)take((size_t)256 * 256 * 2);
  P.hx = (u16*)take((size_t)NT * 1024 * 2);
  P.proj = (u16*)take((size_t)NT * PSTR * 2);
  P.vtx = (u16*)take((size_t)8 * 256 * 4096 * 2);
  P.vtc = (u16*)take((size_t)8 * 256 * 512 * 2);
  P.natvx = (u16*)take((size_t)8 * 384 * 2048 * 2);
  P.natvc = (u16*)take((size_t)8 * 384 * 256 * 2);
  P.natkx = (u16*)take((size_t)8 * 384 * 2048 * 2);
  P.natkc = (u16*)take((size_t)8 * 384 * 256 * 2);
  P.ctxw = (float*)take((size_t)NC * 1024 * 4);
  P.kv = (u16*)take((size_t)NUNIT_G * 4608 * 2);
  P.dec = (float*)take((size_t)NUNIT_G * 48 * 4);
  P.gb = (float*)take((size_t)NUNIT_G * 3072 * 4);
  P.bar = (unsigned*)take((size_t)XCD_BAR_WORDS * 4);
  if (off > ws_size) { fprintf(stderr, "workspace too small: need %zu have %zu\n", off, ws_size); return; }
  if (hipMemsetAsync(P.bar, 0, (size_t)XCD_BAR_WORDS * 4, stream) != hipSuccess) { fprintf(stderr, "memset of barrier words failed\n"); return; }
  int ph_lo = 0, ph_hi = 2 + 6 * DEPTH, coop = 1;
  void* args[] = {&P, &ph_lo, &ph_hi, &coop};
  hipError_t e = hipLaunchCooperativeKernel((const void*)mega, dim3(grid_blocks), dim3(NTHREADS), args, LDS_BYTES, stream);
  if (e != hipSuccess) fprintf(stderr, "cooperative launch failed: %s (grid %d)\n", hipGetErrorString(e), grid_blocks);
}
```
